# Optimizing an MI355X kernel written in HIP

```python
import math
import jax, jax.numpy as jnp
from jax import lax
import numpy as np

D_MODEL = 1024
BATCH = 8
SEQ = 2048
DEPTH = 1
DEC_BATCH = 128
DEC_SEQ = 1
PAST_LEN = 16384
PAGE_SIZE = 128

S5_GROUP = 16
S5_GROUPS = D_MODEL // 32
S5_WIDTH = S5_GROUPS * S5_GROUP
S5_STATE = 64
S5_DT_MIN = 0.001
S5_DT_MAX = 0.1

M2_INNER = D_MODEL
M2_HEADDIM = 64
M2_HEADS = M2_INNER // M2_HEADDIM
M2_GROUPS = 4
M2_HPG = M2_HEADS // M2_GROUPS
M2_STATE = 128
M2_CONV = 4
M2_CHUNK = 128
M2_CONV_DIM = M2_INNER + 2 * M2_GROUPS * M2_STATE
M2_DT_MIN = 0.001
M2_DT_MAX = 0.1

PEER_HEADS = 8
PEER_NKEYS = 128
PEER_TOPK = 16
PEER_DKEY = 256
PEER_DHALF = PEER_DKEY // 2
PEER_EXPERTS = PEER_NKEYS * PEER_NKEYS
PEER_BLOCK = 128

IN_DIM = S5_WIDTH + M2_INNER + M2_CONV_DIM + M2_HEADS + 2 * D_MODEL
NORM_EPS = 1e-6
GNORM_EPS = 1e-5

kernel_name = "hybrid_s5_ssd_peer_decode_step"


def rmsnorm(x, g):
    xf = x.astype(jnp.float32)
    out = xf * lax.rsqrt(jnp.mean(xf * xf, axis=-1, keepdims=True) + NORM_EPS)
    return (out * g.astype(jnp.float32)).astype(x.dtype)


def modulate(h, shift, scale):
    return h * (1 + scale[:, None, :]) + shift[:, None, :]


def _complex_affine_combine(e1, e2):
    a1r, a1i, b1r, b1i = e1
    a2r, a2i, b2r, b2i = e2
    return (a2r * a1r - a2i * a1i,
            a2r * a1i + a2i * a1r,
            a2r * b1r - a2i * b1i + b2r,
            a2r * b1i + a2i * b1r + b2i)


def s5_branch(u, a_re, a_im, log_dt, b_re, b_im, c_re, c_im, d, w_glu, b_glu, s0_re, s0_im):
    f32 = jnp.float32
    bsz, L, _ = u.shape
    ug = u.astype(f32).reshape(bsz, L, S5_GROUPS, S5_GROUP)
    dt = jnp.exp(log_dt.astype(f32))[:, None]
    ar = a_re.astype(f32)
    ai = a_im.astype(f32)
    mag = jnp.exp(dt * ar)
    abar_re = mag * jnp.cos(dt * ai)
    abar_im = mag * jnp.sin(dt * ai)
    den = ar * ar + ai * ai
    nr = abar_re - 1.0
    f_re = (nr * ar + abar_im * ai) / den
    f_im = (abar_im * ar - nr * ai) / den
    br = b_re.astype(f32)
    bi = b_im.astype(f32)
    bbar_re = f_re[..., None] * br - f_im[..., None] * bi
    bbar_im = f_re[..., None] * bi + f_im[..., None] * br
    bu_re = jnp.einsum('gph,blgh->blgp', bbar_re, ug)
    bu_im = jnp.einsum('gph,blgh->blgp', bbar_im, ug)
    if s0_re is not None:
        sr = s0_re.astype(f32)
        si = s0_im.astype(f32)
        bu_re = bu_re.at[:, 0].add(abar_re * sr - abar_im * si)
        bu_im = bu_im.at[:, 0].add(abar_re * si + abar_im * sr)
    shp = bu_re.shape
    elems = (jnp.broadcast_to(abar_re, shp), jnp.broadcast_to(abar_im, shp), bu_re, bu_im)
    _, _, s_re, s_im = lax.associative_scan(_complex_affine_combine, elems, axis=1)
    y = (jnp.einsum('ghp,blgp->blgh', c_re.astype(f32), s_re)
         - jnp.einsum('ghp,blgp->blgh', c_im.astype(f32), s_im)
         + d.astype(f32) * ug)
    y = jax.nn.gelu(y.reshape(bsz, L, S5_WIDTH), approximate=False)
    y = y * jax.nn.sigmoid(y @ w_glu.astype(f32) + b_glu.astype(f32))
    return y.astype(u.dtype), s_re[:, -1].astype(u.dtype), s_im[:, -1].astype(u.dtype)


def causal_conv(xbc, conv_w, conv_b, buf):
    bsz, L, C = xbc.shape
    if buf is None:
        buf = jnp.zeros((bsz, M2_CONV - 1, C), xbc.dtype)
    xp = jnp.concatenate([buf.astype(xbc.dtype), xbc], axis=1)
    out = conv_b + xp[:, 0:L] * conv_w[0]
    for k in range(1, M2_CONV):
        out = out + xp[:, k:k + L] * conv_w[k]
    return jax.nn.silu(out), xp[:, xp.shape[1] - (M2_CONV - 1):]


def ssd(x, dt, a, bm, cm, h0):
    bsz, L = x.shape[0], x.shape[1]
    q = M2_CHUNK if L % M2_CHUNK == 0 else L
    nc = L // q
    x = x.reshape(bsz, nc, q, M2_GROUPS, M2_HPG, M2_HEADDIM)
    dt = dt.reshape(bsz, nc, q, M2_GROUPS, M2_HPG)
    bm = bm.reshape(bsz, nc, q, M2_GROUPS, M2_STATE)
    cm = cm.reshape(bsz, nc, q, M2_GROUPS, M2_STATE)
    cs = jnp.cumsum(dt * a, axis=2)
    seg = cs[:, :, :, None] - cs[:, :, None, :]
    mask = jnp.tril(jnp.ones((q, q), dtype=bool))[:, :, None, None]
    decay = jnp.exp(jnp.where(mask, seg, -jnp.inf))
    xdt = x * dt[..., None]
    cb = jnp.einsum('bcign,bcjgn->bcijg', cm, bm)
    y_diag = jnp.einsum('bcijgr,bcjgrp->bcigrp', cb[..., None] * decay, xdt)
    decay_st = jnp.exp(cs[:, :, -1:] - cs)
    states = jnp.einsum('bcjgn,bcjgr,bcjgrp->bcgrpn', bm, decay_st, xdt)
    chunk_decay = jnp.exp(cs[:, :, -1])

    def step(h, inp):
        dec, st = inp
        return dec[..., None, None] * h + st, h

    h_last, h_prev = lax.scan(step, h0, (jnp.moveaxis(chunk_decay, 1, 0), jnp.moveaxis(states, 1, 0)))
    h_prev = jnp.moveaxis(h_prev, 0, 1)
    y_off = jnp.einsum('bcign,bcgrpn,bcigr->bcigrp', cm, h_prev, jnp.exp(cs))
    y = (y_diag + y_off).reshape(bsz, L, M2_GROUPS, M2_HPG, M2_HEADDIM)
    return y, h_last


def mamba2_branch(z, xbc, dt_raw, conv_w, conv_b, dt_bias, a_log, d_skip, g_norm, conv_buf, h0):
    f32 = jnp.float32
    bsz, L, _ = z.shape
    xbc, new_buf = causal_conv(xbc, conv_w, conv_b, conv_buf)
    xs = xbc[..., :M2_INNER].astype(f32).reshape(bsz, L, M2_GROUPS, M2_HPG, M2_HEADDIM)
    bm = xbc[..., M2_INNER:M2_INNER + M2_GROUPS * M2_STATE].astype(f32).reshape(bsz, L, M2_GROUPS, M2_STATE)
    cm = xbc[..., M2_INNER + M2_GROUPS * M2_STATE:].astype(f32).reshape(bsz, L, M2_GROUPS, M2_STATE)
    dt = jax.nn.softplus(dt_raw.astype(f32) + dt_bias.astype(f32)).reshape(bsz, L, M2_GROUPS, M2_HPG)
    a = -jnp.exp(a_log.astype(f32)).reshape(M2_GROUPS, M2_HPG)
    if h0 is None:
        h0 = jnp.zeros((bsz, M2_GROUPS, M2_HPG, M2_HEADDIM, M2_STATE), f32)
    else:
        h0 = h0.astype(f32).reshape(bsz, M2_GROUPS, M2_HPG, M2_HEADDIM, M2_STATE)
    y, h_last = ssd(xs, dt, a, bm, cm, h0)
    y = y + d_skip.astype(f32).reshape(M2_GROUPS, M2_HPG)[..., None] * xs
    y = y.reshape(bsz, L, M2_INNER) * jax.nn.silu(z.astype(f32))
    yg = y.reshape(bsz, L, M2_GROUPS, M2_INNER // M2_GROUPS)
    yg = yg * lax.rsqrt(jnp.mean(yg * yg, axis=-1, keepdims=True) + GNORM_EPS)
    y = yg.reshape(bsz, L, M2_INNER) * g_norm.astype(f32)
    h_last = h_last.reshape(bsz, M2_HEADS, M2_HEADDIM, M2_STATE)
    return y.astype(z.dtype), new_buf, h_last.astype(z.dtype)


def peer(x2, w_query, sub_keys, expert_down, expert_up):
    f32 = jnp.float32
    bsz, L, D = x2.shape
    T = bsz * L
    nblk = -(-T // PEER_BLOCK)
    xt = x2.reshape(T, D)
    xt = jnp.pad(xt, ((0, nblk * PEER_BLOCK - T), (0, 0))).reshape(nblk, PEER_BLOCK, D)
    keys = sub_keys.astype(f32)

    def block(xb):
        qv = (xb @ w_query).astype(f32).reshape(PEER_BLOCK, PEER_HEADS, 2, PEER_DHALF)
        s = jnp.einsum('thsd,hskd->thsk', qv, keys)
        sv, si = lax.top_k(s, PEER_TOPK)
        cand = sv[:, :, 0, :, None] + sv[:, :, 1, None, :]
        cidx = si[:, :, 0, :, None] * PEER_NKEYS + si[:, :, 1, None, :]
        fv, fi = lax.top_k(cand.reshape(PEER_BLOCK, PEER_HEADS, PEER_TOPK * PEER_TOPK), PEER_TOPK)
        eidx = jnp.take_along_axis(cidx.reshape(PEER_BLOCK, PEER_HEADS, PEER_TOPK * PEER_TOPK), fi, axis=-1)
        g = jax.nn.softmax(fv, axis=-1)
        u = expert_down[eidx]
        act = jax.nn.gelu(jnp.einsum('thkd,td->thk', u, xb).astype(f32), approximate=False) * g
        v = expert_up[eidx]
        return jnp.einsum('thk,thkd->td', act.astype(v.dtype), v)

    out = lax.map(block, xt)
    return out.reshape(nblk * PEER_BLOCK, D)[:T].reshape(bsz, L, D).astype(x2.dtype)


def trunk(x, c, state, w_ada, b_ada, g_norm1, g_norm2, w_in, s5_a_re, s5_a_im, s5_log_dt, s5_b_re, s5_b_im,
          s5_c_re, s5_c_im, s5_d, s5_w_glu, s5_b_glu, w_branch_a, conv_w, conv_b, dt_bias, a_log, d_skip,
          g_ssm_norm, w_branch_b, w_out, w_query, sub_keys, expert_down, expert_up, g_final, w_ada_final,
          b_ada_final):
    sc = jax.nn.silu(c)
    o1 = S5_WIDTH
    o2 = o1 + M2_INNER
    o3 = o2 + M2_CONV_DIM
    o4 = o3 + M2_HEADS
    new_re, new_im, new_ssm, new_conv = [], [], [], []
    for l in range(DEPTH):
        if state is None:
            s0r, s0i, h0, buf = None, None, None, None
        else:
            s0r, s0i, h0, buf = state[0][l], state[1][l], state[2][l], state[3][l]
        mod = sc @ w_ada[l] + b_ada[l]
        sh1, sc1, gt1, sh2, sc2, gt2 = jnp.split(mod, 6, axis=-1)
        h = modulate(rmsnorm(x, g_norm1[l]), sh1, sc1)
        proj = h @ w_in[l]
        u = proj[..., :o1]
        z = proj[..., o1:o2]
        xbc = proj[..., o2:o3]
        dt_raw = proj[..., o3:o4]
        gates = jax.nn.sigmoid(proj[..., o4:])
        ya, sr, si = s5_branch(u, s5_a_re[l], s5_a_im[l], s5_log_dt[l], s5_b_re[l], s5_b_im[l], s5_c_re[l],
                               s5_c_im[l], s5_d[l], s5_w_glu[l], s5_b_glu[l], s0r, s0i)
        yb, nbuf, hl = mamba2_branch(z, xbc, dt_raw, conv_w[l], conv_b[l], dt_bias[l], a_log[l], d_skip[l],
                                     g_ssm_norm[l], buf, h0)
        merged = gates[..., :D_MODEL] * (ya @ w_branch_a[l]) + gates[..., D_MODEL:] * (yb @ w_branch_b[l])
        x = x + gt1[:, None, :] * (merged @ w_out[l])
        h2 = modulate(rmsnorm(x, g_norm2[l]), sh2, sc2)
        x = x + gt2[:, None, :] * peer(h2, w_query[l], sub_keys[l], expert_down[l], expert_up[l])
        new_re.append(sr)
        new_im.append(si)
        new_ssm.append(hl)
        new_conv.append(nbuf)
    shf, scf = jnp.split(sc @ w_ada_final + b_ada_final, 2, axis=-1)
    y = modulate(rmsnorm(x, g_final), shf, scf)
    return y, jnp.stack(new_re), jnp.stack(new_im), jnp.stack(new_ssm), jnp.stack(new_conv)


def setup_inputs(seed: int = 0) -> dict:
    key = jax.random.key(seed)
    ks = iter(jax.random.split(key, 48))
    f32 = jnp.float32
    nrm = lambda shape, s: jax.random.normal(next(ks), shape, f32) * s
    D = D_MODEL
    inp = {}
    inp['x_prompt'] = nrm((BATCH, SEQ, D), 1.0)
    inp['x_sample'] = nrm((DEC_BATCH, DEC_SEQ, D), 1.0)
    inp['state_s5_re'] = nrm((DEPTH, DEC_BATCH, S5_GROUPS, S5_STATE), 0.1)
    inp['state_s5_im'] = nrm((DEPTH, DEC_BATCH, S5_GROUPS, S5_STATE), 0.1)
    inp['state_ssm'] = nrm((DEPTH, DEC_BATCH, M2_HEADS, M2_HEADDIM, M2_STATE), 0.1)
    inp['state_conv'] = nrm((DEPTH, DEC_BATCH, M2_CONV - 1, M2_CONV_DIM), 1.0)
    inp['c_prompt'] = nrm((BATCH, D), 1.0)
    inp['c_sample'] = nrm((DEC_BATCH, D), 1.0)
    inp['w_ada'] = nrm((DEPTH, D, 6 * D), 0.5 * D ** -0.5)
    inp['b_ada'] = nrm((DEPTH, 6 * D), 0.01)
    inp['g_norm1'] = 1.0 + nrm((DEPTH, D), 0.05)
    inp['g_norm2'] = 1.0 + nrm((DEPTH, D), 0.05)
    inp['w_in'] = nrm((DEPTH, D, IN_DIM), D ** -0.5)
    inp['s5_a_re'] = -0.5 + nrm((DEPTH, S5_GROUPS, S5_STATE), 0.01)
    inp['s5_a_im'] = jnp.pi * jnp.arange(S5_STATE, dtype=f32) + nrm((DEPTH, S5_GROUPS, S5_STATE), 0.01)
    inp['s5_log_dt'] = jax.random.uniform(next(ks), (DEPTH, S5_GROUPS), f32, math.log(S5_DT_MIN), math.log(S5_DT_MAX))
    inp['s5_b_re'] = nrm((DEPTH, S5_GROUPS, S5_STATE, S5_GROUP), (2 * S5_GROUP) ** -0.5)
    inp['s5_b_im'] = nrm((DEPTH, S5_GROUPS, S5_STATE, S5_GROUP), (2 * S5_GROUP) ** -0.5)
    inp['s5_c_re'] = nrm((DEPTH, S5_GROUPS, S5_GROUP, S5_STATE), S5_STATE ** -0.5)
    inp['s5_c_im'] = nrm((DEPTH, S5_GROUPS, S5_GROUP, S5_STATE), S5_STATE ** -0.5)
    inp['s5_d'] = nrm((DEPTH, S5_GROUPS, S5_GROUP), 1.0)
    inp['s5_w_glu'] = nrm((DEPTH, S5_WIDTH, S5_WIDTH), S5_WIDTH ** -0.5)
    inp['s5_b_glu'] = nrm((DEPTH, S5_WIDTH), 0.01)
    inp['w_branch_a'] = nrm((DEPTH, S5_WIDTH, D), S5_WIDTH ** -0.5)
    inp['conv_w'] = nrm((DEPTH, M2_CONV, M2_CONV_DIM), M2_CONV ** -0.5)
    inp['conv_b'] = nrm((DEPTH, M2_CONV_DIM), 0.01)
    dt0 = jnp.exp(jax.random.uniform(next(ks), (DEPTH, M2_HEADS), f32, math.log(M2_DT_MIN), math.log(M2_DT_MAX)))
    inp['dt_bias'] = dt0 + jnp.log(-jnp.expm1(-dt0))
    inp['a_log'] = jnp.log(jax.random.uniform(next(ks), (DEPTH, M2_HEADS), f32, 1.0, 16.0))
    inp['d_skip'] = 1.0 + nrm((DEPTH, M2_HEADS), 0.1)
    inp['g_ssm_norm'] = 1.0 + nrm((DEPTH, M2_INNER), 0.05)
    inp['w_branch_b'] = nrm((DEPTH, M2_INNER, D), M2_INNER ** -0.5)
    inp['w_out'] = nrm((DEPTH, D, D), D ** -0.5)
    inp['w_query'] = nrm((DEPTH, D, PEER_HEADS * PEER_DKEY), D ** -0.5)
    inp['sub_keys'] = nrm((DEPTH, PEER_HEADS, 2, PEER_NKEYS, PEER_DHALF), PEER_DHALF ** -0.5)
    inp['expert_down'] = nrm((DEPTH, PEER_EXPERTS, D), D ** -0.5)
    inp['expert_up'] = nrm((DEPTH, PEER_EXPERTS, D), PEER_HEADS ** -0.5)
    inp['g_final'] = 1.0 + nrm((D,), 0.05)
    inp['w_ada_final'] = nrm((D, 2 * D), 0.5 * D ** -0.5)
    inp['b_ada_final'] = nrm((2 * D,), 0.01)
    return inp


def reference(x_prompt, x_sample, state_s5_re, state_s5_im, state_ssm, state_conv, c_prompt, c_sample,
              w_ada, b_ada, g_norm1, g_norm2, w_in, s5_a_re, s5_a_im, s5_log_dt, s5_b_re, s5_b_im, s5_c_re,
              s5_c_im, s5_d, s5_w_glu, s5_b_glu, w_branch_a, conv_w, conv_b, dt_bias, a_log, d_skip, g_ssm_norm,
              w_branch_b, w_out, w_query, sub_keys, expert_down, expert_up, g_final, w_ada_final, b_ada_final):
    weights = (w_ada, b_ada, g_norm1, g_norm2, w_in, s5_a_re, s5_a_im, s5_log_dt, s5_b_re, s5_b_im, s5_c_re,
               s5_c_im, s5_d, s5_w_glu, s5_b_glu, w_branch_a, conv_w, conv_b, dt_bias, a_log, d_skip, g_ssm_norm,
               w_branch_b, w_out, w_query, sub_keys, expert_down, expert_up, g_final, w_ada_final, b_ada_final)
    y_prompt, s5_re_p, s5_im_p, ssm_p, conv_p = trunk(x_prompt, c_prompt, None, *weights)
    y_sample, s5_re_s, s5_im_s, ssm_s, conv_s = trunk(
        x_sample, c_sample, (state_s5_re, state_s5_im, state_ssm, state_conv), *weights)
    return (y_prompt, y_sample, s5_re_p, s5_im_p, ssm_p, conv_p, s5_re_s, s5_im_s, ssm_s, conv_s)
```

```cpp
#include <hip/hip_runtime.h>
#include <hip/hip_cooperative_groups.h>
#include <cstdio>
#include <cstdint>
namespace cg = cooperative_groups;

typedef unsigned short bf16_t;
using bf16x8 = __attribute__((ext_vector_type(8))) short;
using bf16x2v = __attribute__((ext_vector_type(2))) __bf16;
using f32x4 = __attribute__((ext_vector_type(4))) float;
using f32x16 = __attribute__((ext_vector_type(16))) float;
#define DI __device__ __forceinline__

struct P { const float* in[39]; float* out; char* ws; };

constexpr int TT = 16512, TP = 16384;
constexpr size_t OFF_WINT = 0;
constexpr size_t OFF_WGLUT = OFF_WINT + 12058624;
constexpr size_t OFF_WAT = OFF_WGLUT + 524288;
constexpr size_t OFF_WBT = OFF_WAT + 1048576;
constexpr size_t OFF_WOUTT = OFF_WBT + 2097152;
constexpr size_t OFF_WQT = OFF_WOUTT + 2097152;
constexpr size_t OFF_KEYS = OFF_WQT + 4194304;
constexpr size_t OFF_SCB = OFF_KEYS + 524288;
constexpr size_t OFF_MOD = OFF_SCB + 524288;
constexpr size_t OFF_MODF = OFF_MOD + 3342336;
constexpr size_t OFF_DTB = OFF_MODF + 1114112;
constexpr size_t OFF_ACT = OFF_DTB + 1056768;
constexpr size_t OFF_U = OFF_ACT + 33816576;
constexpr size_t OFF_Z = OFF_U + 16908288;
constexpr size_t OFF_XBC = OFF_Z + 33816576;
constexpr size_t OFF_GATES = OFF_XBC + 67633152;
constexpr size_t OFF_YS5 = OFF_GATES + 67633152;
constexpr size_t OFF_YSSD = OFF_YS5 + 16908288;
constexpr size_t OFF_BAR = OFF_YSSD + 33816576;
constexpr size_t OFF_TAILS = OFF_BAR + 16384;
constexpr size_t OFF_E8 = OFF_TAILS + 1572864;
constexpr size_t WS_NEED = OFF_E8 + 33554432 + 131072;

constexpr size_t O_Y = 0;
constexpr size_t O_S5RE_P = 16908288;
constexpr size_t O_S5IM_P = O_S5RE_P + 16384;
constexpr size_t O_SSM_P = O_S5IM_P + 16384;
constexpr size_t O_CONV_P = O_SSM_P + 1048576;
constexpr size_t O_S5RE_S = O_CONV_P + 49152;
constexpr size_t O_S5IM_S = O_S5RE_S + 262144;
constexpr size_t O_SSM_S = O_S5IM_S + 262144;
constexpr size_t O_CONV_S = O_SSM_S + 16777216;

constexpr int SMEM_BYTES = 80400;

DI float bf2f(bf16_t b) { return __uint_as_float(((unsigned)b) << 16); }
DI float bflo(unsigned u) { return __uint_as_float(u << 16); }
DI float bfhi(unsigned u) { return __uint_as_float(u & 0xffff0000u); }
typedef __attribute__((ext_vector_type(2))) float f2v_t;
typedef __attribute__((ext_vector_type(2))) __bf16 b2v_t;
DI unsigned cvtpk(float lo, float hi) { f2v_t v = {lo, hi}; b2v_t r = __builtin_convertvector(v, b2v_t); return __builtin_bit_cast(unsigned, r); }
typedef __attribute__((ext_vector_type(4))) unsigned u32x4_t;
DI bf16x8 mk8(unsigned a, unsigned b, unsigned c, unsigned d) { u32x4_t v = {a, b, c, d}; return __builtin_bit_cast(bf16x8, v); }
DI bf16_t f2bf(float f) { return (bf16_t)(cvtpk(f, 0.f) & 0xffffu); }
DI float siluf(float x) { return x * __builtin_amdgcn_rcpf(1.f + __expf(-x)); }
DI float sigmf(float x) { return __builtin_amdgcn_rcpf(1.f + __expf(-x)); }
DI float erf_as(float x) {
  const float ax = fabsf(x);
  const float t = __builtin_amdgcn_rcpf(1.f + 0.3275911f * ax);
  const float poly = t * (0.254829592f + t * (-0.284496736f + t * (1.421413741f + t * (-1.453152027f + t * 1.061405429f))));
  const float r = 1.f - poly * __expf(-ax * ax);
  return copysignf(r, x);
}
DI float geluf(float x) { return 0.5f * x * (1.f + erf_as(x * 0.70710678118654752f)); }
DI float dot2(unsigned a, unsigned b, float acc) {
  return __builtin_amdgcn_fdot2_f32_bf16(__builtin_bit_cast(bf16x2v, a), __builtin_bit_cast(bf16x2v, b), acc, false);
}
DI float wave_sum(float v) {
#pragma unroll
  for (int o = 32; o; o >>= 1) v += __shfl_xor(v, o);
  return v;
}
DI float wave_max(float v) {
#pragma unroll
  for (int o = 32; o; o >>= 1) v = fmaxf(v, __shfl_xor(v, o));
  return v;
}
template <int CTRL> DI float dppf(float x) {
  return __builtin_bit_cast(float, __builtin_amdgcn_mov_dpp(__builtin_bit_cast(int, x), CTRL, 0xf, 0xf, true));
}
DI float row16_max(float m) {
  m = fmaxf(m, dppf<0xB1>(m)); m = fmaxf(m, dppf<0x4E>(m)); m = fmaxf(m, dppf<0x141>(m)); m = fmaxf(m, dppf<0x128>(m));
  return m;
}
DI float row16_sum(float s) {
  s += dppf<0xB1>(s); s += dppf<0x4E>(s); s += dppf<0x141>(s); s += dppf<0x128>(s);
  return s;
}
DI float xrow16_sum(float x) {
  auto a = __builtin_amdgcn_permlane16_swap(__float_as_uint(x), __float_as_uint(x), false, false);
  x = __uint_as_float(a[0]) + __uint_as_float(a[1]);
  auto b = __builtin_amdgcn_permlane32_swap(__float_as_uint(x), __float_as_uint(x), false, false);
  return __uint_as_float(b[0]) + __uint_as_float(b[1]);
}
DI float wave_sum_fast(float s) { return xrow16_sum(row16_sum(s)); }
DI float wave_incl_scan(float v) {
  v += __builtin_bit_cast(float, __builtin_amdgcn_update_dpp(0, __builtin_bit_cast(int, v), 0x111, 0xf, 0xf, true));
  v += __builtin_bit_cast(float, __builtin_amdgcn_update_dpp(0, __builtin_bit_cast(int, v), 0x112, 0xf, 0xf, true));
  v += __builtin_bit_cast(float, __builtin_amdgcn_update_dpp(0, __builtin_bit_cast(int, v), 0x114, 0xf, 0xf, true));
  v += __builtin_bit_cast(float, __builtin_amdgcn_update_dpp(0, __builtin_bit_cast(int, v), 0x118, 0xf, 0xf, true));
  v += __builtin_bit_cast(float, __builtin_amdgcn_update_dpp(0, __builtin_bit_cast(int, v), 0x142, 0xa, 0xf, false));
  v += __builtin_bit_cast(float, __builtin_amdgcn_update_dpp(0, __builtin_bit_cast(int, v), 0x143, 0xc, 0xf, false));
  return v;
}
DI int mrow(int t) { return t < TP ? (t >> 11) : (8 + t - TP); }
DI void store8bf(bf16_t* dst, const float (&v)[8]) {
  uint4 o; o.x = cvtpk(v[0], v[1]); o.y = cvtpk(v[2], v[3]); o.z = cvtpk(v[4], v[5]); o.w = cvtpk(v[6], v[7]);
  *(uint4*)dst = o;
}
DI void unpack8(const uint4& u, float (&v)[8]) {
  v[0] = bflo(u.x); v[1] = bfhi(u.x); v[2] = bflo(u.y); v[3] = bfhi(u.y);
  v[4] = bflo(u.z); v[5] = bfhi(u.z); v[6] = bflo(u.w); v[7] = bfhi(u.w);
}

DI void tconv_tile(const float* __restrict__ src, int ldsrc, int srccol0, int nvalid, int k0,
                   bf16_t* __restrict__ dst, int lddst, int dstrow0, char* smem) {
  float* tile = (float*)smem;
  const int tid = threadIdx.x;
  const int n4 = (tid & 15) * 4, kb = tid >> 4;
#pragma unroll
  for (int i = 0; i < 4; ++i) {
    int kk = kb + 16 * i;
    float4 v = make_float4(0.f, 0.f, 0.f, 0.f);
    if (n4 < nvalid) v = *(const float4*)(src + (size_t)(k0 + kk) * ldsrc + srccol0 + n4);
    float* tp = tile + kk * 65 + n4;
    tp[0] = v.x; tp[1] = v.y; tp[2] = v.z; tp[3] = v.w;
  }
  __syncthreads();
  const int n = tid >> 2, kq = (tid & 3) * 16;
  unsigned o[8];
#pragma unroll
  for (int i = 0; i < 8; ++i) o[i] = cvtpk(tile[(kq + 2 * i) * 65 + n], tile[(kq + 2 * i + 1) * 65 + n]);
  const int nrow = dstrow0 + n, kk = k0 + kq;
  uint4* d = (uint4*)(dst + ((size_t)((nrow >> 7) * (lddst >> 5) + (kk >> 5)) * 128 + (nrow & 127)) * 32 + (kk & 31));
  d[0] = make_uint4(o[0], o[1], o[2], o[3]);
  d[1] = make_uint4(o[4], o[5], o[6], o[7]);
  __syncthreads();
}

constexpr int LDT = 72;
constexpr int TILE_ELEMS = 128 * LDT;

#define GLDS16(g, l) __builtin_amdgcn_global_load_lds((const unsigned*)(g), (unsigned*)(l), 16, 0, 0)
DI void gemm_kloop(const bf16_t* __restrict__ A, int lda, const bf16_t* __restrict__ B, int ldb, int K,
                   f32x4 (&acc)[4][4], char* smem) {
  const int tid = threadIdx.x, lane = tid & 63, wid = tid >> 6, wr = wid >> 1, wc = wid & 1, fr = lane & 15, fq = lane >> 4;
  const int r0 = tid >> 2;
  const int fsw = (0x78 >> (2 * ((r0 >> 2) & 3))) & 3;
  const int csrc = ((tid & 3) ^ fsw) * 8;
  const bf16_t* Ap0 = A + (size_t)r0 * lda + csrc;
  const bf16_t* Ap1 = A + (size_t)(r0 + 64) * lda + csrc;
  const bf16_t* Bp0 = B + r0 * 32 + csrc;
  const bf16_t* Bp1 = Bp0 + 2048;
  char* lw = smem + tid * 16;
  const int posl = (fq ^ ((0x78 >> (2 * ((fr >> 2) & 3))) & 3)) * 16;
  const char* ardA = smem + (wr * 64 + fr) * 64 + posl;
  const char* ardB = smem + 8192 + (wc * 64 + fr) * 64 + posl;
  const int nk = K >> 5;
  auto issue = [&](int kt) __attribute__((always_inline)) {
    char* base = lw + (kt & 3) * 16384;
    GLDS16(Ap0 + kt * 32, base);
    GLDS16(Ap1 + kt * 32, base + 4096);
    GLDS16(Bp0 + kt * 4096, base + 8192);
    GLDS16(Bp1 + kt * 4096, base + 12288);
  };
  issue(0); issue(1); issue(2);
#pragma unroll 1
  for (int kt = 0; kt < nk; ++kt) {
    if (kt + 2 < nk) asm volatile("s_waitcnt vmcnt(8)" ::: "memory");
    else if (kt + 1 < nk) asm volatile("s_waitcnt vmcnt(4)" ::: "memory");
    else asm volatile("s_waitcnt vmcnt(0)" ::: "memory");
    __builtin_amdgcn_s_barrier();
    if (kt + 3 < nk) issue(kt + 3);
    const char* pa = ardA + (kt & 3) * 16384;
    const char* pb = ardB + (kt & 3) * 16384;
    bf16x8 a[4], b[4];
#pragma unroll
    for (int m = 0; m < 4; ++m) a[m] = *(const bf16x8*)(pa + m * 1024);
#pragma unroll
    for (int n = 0; n < 4; ++n) b[n] = *(const bf16x8*)(pb + n * 1024);
#pragma unroll
    for (int m = 0; m < 4; ++m)
#pragma unroll
      for (int n = 0; n < 4; ++n)
        acc[m][n] = __builtin_amdgcn_mfma_f32_16x16x32_bf16(a[m], b[n], acc[m][n], 0, 0, 0);
  }
  __syncthreads();
}

DI void gemm_kloop_n256(const bf16_t* __restrict__ A, int lda, const bf16_t* __restrict__ B, int K,
                        f32x4 (&acc)[4][8], char* smem) {
  const int tid = threadIdx.x, lane = tid & 63, wid = tid >> 6, wr = wid >> 1, wc = wid & 1, fr = lane & 15, fq = lane >> 4;
  const int r0 = tid >> 2;
  const int fsw = (0x78 >> (2 * ((r0 >> 2) & 3))) & 3;
  const int csrc = ((tid & 3) ^ fsw) * 8;
  const bf16_t* Ap0 = A + (size_t)r0 * lda + csrc;
  const bf16_t* Ap1 = A + (size_t)(r0 + 64) * lda + csrc;
  const bf16_t* Bp0 = B + r0 * 32 + csrc;
  const bf16_t* Bp2 = Bp0 + (size_t)128 * K;
  char* lw = smem + tid * 16;
  const int posl = (fq ^ ((0x78 >> (2 * ((fr >> 2) & 3))) & 3)) * 16;
  const char* ardA = smem + (wr * 64 + fr) * 64 + posl;
  const char* ardB = smem + 8192 + (wc * 128 + fr) * 64 + posl;
  const int nk = K >> 5;
  auto issue = [&](int kt, int stg) __attribute__((always_inline)) {
    char* base = lw + stg * 24576;
    GLDS16(Ap0 + kt * 32, base);
    GLDS16(Ap1 + kt * 32, base + 4096);
    GLDS16(Bp0 + kt * 4096, base + 8192);
    GLDS16(Bp0 + kt * 4096 + 2048, base + 12288);
    GLDS16(Bp2 + kt * 4096, base + 16384);
    GLDS16(Bp2 + kt * 4096 + 2048, base + 20480);
  };
  issue(0, 0); issue(1, 1);
  int stg = 0;
#pragma unroll 1
  for (int kt = 0; kt < nk; ++kt) {
    if (kt + 1 < nk) asm volatile("s_waitcnt vmcnt(6)" ::: "memory");
    else asm volatile("s_waitcnt vmcnt(0)" ::: "memory");
    __builtin_amdgcn_s_barrier();
    const int stg2 = (stg == 0) ? 2 : stg - 1;
    if (kt + 2 < nk) issue(kt + 2, stg2);
    const char* pa = ardA + stg * 24576;
    const char* pb = ardB + stg * 24576;
    bf16x8 a[4], b[8];
#pragma unroll
    for (int m = 0; m < 4; ++m) a[m] = *(const bf16x8*)(pa + m * 1024);
#pragma unroll
    for (int n = 0; n < 8; ++n) b[n] = *(const bf16x8*)(pb + n * 1024);
    __builtin_amdgcn_sched_barrier(0);
    __builtin_amdgcn_s_setprio(1);
#pragma unroll
    for (int m = 0; m < 4; ++m)
#pragma unroll
      for (int n = 0; n < 8; ++n)
        acc[m][n] = __builtin_amdgcn_mfma_f32_16x16x32_bf16(a[m], b[n], acc[m][n], 0, 0, 0);
    __builtin_amdgcn_s_setprio(0);
    stg = (stg == 2) ? 0 : stg + 1;
  }
  __syncthreads();
}
DI void zero_acc8(f32x4 (&acc)[4][8]) {
#pragma unroll
  for (int m = 0; m < 4; ++m)
#pragma unroll
    for (int n = 0; n < 8; ++n) acc[m][n] = f32x4{0.f, 0.f, 0.f, 0.f};
}
constexpr int CS16 = 264;
DI void stage_all_bf16(f32x4 (&acc)[4][8], char* smem) {
  const int tid = threadIdx.x, lane = tid & 63, wid = tid >> 6, wr = wid >> 1, wc = wid & 1, fr = lane & 15, fq = lane >> 4;
  bf16_t* Cs = (bf16_t*)smem;
#pragma unroll
  for (int m = 0; m < 4; ++m)
#pragma unroll
    for (int n = 0; n < 8; ++n)
#pragma unroll
      for (int r = 0; r < 4; ++r)
        Cs[(wr * 64 + m * 16 + fq * 4 + r) * CS16 + wc * 128 + n * 16 + fr] = f2bf(acc[m][n][r]);
  __syncthreads();
}
DI void cs16_load8(const bf16_t* Cs, int row, int col, float (&v)[8]) {
  uint4 u = *(const uint4*)(Cs + row * CS16 + col);
  unpack8(u, v);
}
template <class Epi>
DI void epi_pass16(char* smem, int hh, int row0, int col0, Epi epi) {
  const int tid = threadIdx.x;
  const bf16_t* Cs = (const bf16_t*)smem;
#pragma unroll
  for (int i = 0; i < 8; ++i) {
    int idx = tid + 256 * i;
    int row = idx >> 4, c8 = (idx & 15) * 8;
    float v[8];
    cs16_load8(Cs, row, hh * 128 + c8, v);
    epi(row0 + row, col0 + c8, v);
  }
}
DI void zero_acc(f32x4 (&acc)[4][4]) {
#pragma unroll
  for (int m = 0; m < 4; ++m)
#pragma unroll
    for (int n = 0; n < 4; ++n) acc[m][n] = f32x4{0.f, 0.f, 0.f, 0.f};
}

template <class Epi>
DI void gemm_epilogue(f32x4 (&acc)[4][4], char* smem, int row0, int col0, Epi epi) {
  const int tid = threadIdx.x, lane = tid & 63, wid = tid >> 6, wr = wid >> 1, wc = wid & 1, fr = lane & 15, fq = lane >> 4;
  float* Cs = (float*)smem;
#pragma unroll
  for (int m = 0; m < 4; ++m)
#pragma unroll
    for (int n = 0; n < 4; ++n)
#pragma unroll
      for (int r = 0; r < 4; ++r)
        Cs[(wr * 64 + m * 16 + fq * 4 + r) * 132 + wc * 64 + n * 16 + fr] = acc[m][n][r];
  __syncthreads();
#pragma unroll
  for (int i = 0; i < 8; ++i) {
    int idx = tid + 256 * i;
    int row = idx >> 4, c8 = (idx & 15) * 8;
    float4 x0 = *(const float4*)(Cs + row * 132 + c8);
    float4 x1 = *(const float4*)(Cs + row * 132 + c8 + 4);
    float v[8] = {x0.x, x0.y, x0.z, x0.w, x1.x, x1.y, x1.z, x1.w};
    epi(row0 + row, col0 + c8, v);
  }
  __syncthreads();
}

__device__ void phase0(const P& p, char* smem) {
  bf16_t* WinT = (bf16_t*)(p.ws + OFF_WINT);
  bf16_t* WadaT = (bf16_t*)(p.ws + OFF_YS5);
  bf16_t* WgluT = (bf16_t*)(p.ws + OFF_WGLUT);
  bf16_t* WaT = (bf16_t*)(p.ws + OFF_WAT);
  bf16_t* WbT = (bf16_t*)(p.ws + OFF_WBT);
  bf16_t* WoutT = (bf16_t*)(p.ws + OFF_WOUTT);
  bf16_t* WqT = (bf16_t*)(p.ws + OFF_WQT);
  bf16_t* keysB = (bf16_t*)(p.ws + OFF_KEYS);
  bf16_t* scb = (bf16_t*)(p.ws + OFF_SCB);
  const int tid = threadIdx.x;
  const int NTASK = 2048 + 128 + 128 + 256;
  for (int task = blockIdx.x; task < NTASK; task += gridDim.x) {
    int t = task;
    if (t < 1536) { int nt = t >> 4, kt = t & 15; tconv_tile(p.in[8], 6144, nt * 64, 64, kt * 64, WadaT, 1024, nt * 64, smem); continue; }
    t -= 1536;
    if (t < 512) { int nt = t >> 4, kt = t & 15; tconv_tile(p.in[37], 2048, nt * 64, 64, kt * 64, WadaT, 1024, 6144 + nt * 64, smem); continue; }
    t -= 512;
    if (t < 128) {
      size_t e = (size_t)t * 2048 + tid * 8;
      const float* s = p.in[33] + e;
      float4 a = *(const float4*)s, b = *(const float4*)(s + 4);
      float v[8] = {a.x, a.y, a.z, a.w, b.x, b.y, b.z, b.w};
      store8bf(keysB + e, v);
      continue;
    }
    t -= 128;
    if (t < 128) {
      int e = t * 2048 + tid * 8;
      int r = e >> 10, c = e & 1023;
      float v[8];
      if (r < 136) {
        const float* s = (r < 8) ? (p.in[6] + r * 1024 + c) : (p.in[7] + (r - 8) * 1024 + c);
        float4 a = *(const float4*)s, b = *(const float4*)(s + 4);
        float w[8] = {a.x, a.y, a.z, a.w, b.x, b.y, b.z, b.w};
#pragma unroll
        for (int i = 0; i < 8; ++i) v[i] = siluf(w[i]);
      } else {
#pragma unroll
        for (int i = 0; i < 8; ++i) v[i] = 0.f;
      }
      store8bf(scb + e, v);
      continue;
    }
    t -= 128;
    {
      int e = t * 2048 + tid * 8;
      int b = e >> 12, r = (e >> 11) & 1, ch = e & 2047;
      const float* s = p.in[5] + ((size_t)(b * 3 + r + 1)) * 2048 + ch;
      float* d = p.out + O_CONV_S + ((size_t)(b * 3 + r)) * 2048 + ch;
      *(float4*)d = *(const float4*)s;
      *(float4*)(d + 4) = *(const float4*)(s + 4);
    }
  }
}

__device__ void phase_mod(const P& p, char* smem) {
  const bf16_t* scb = (const bf16_t*)(p.ws + OFF_SCB);
  const bf16_t* WadaT = (const bf16_t*)(p.ws + OFF_YS5);
  float* mod = (float*)(p.ws + OFF_MOD);
  float* modf = (float*)(p.ws + OFF_MODF);
  const float* b_ada = p.in[9];
  const float* b_adaf = p.in[38];
  {
    bf16_t* WinT = (bf16_t*)(p.ws + OFF_WINT);
    const int G = gridDim.x;
    const int nconv = (G > 128) ? (G - 128) : G;
    const int first = (G > 128) ? ((int)blockIdx.x - 128) : (int)blockIdx.x;
    if (first >= 0) {
      for (int t = first; t < 1472; t += nconv) {
        int nt = t >> 4, kt = t & 15, n0 = nt * 64, src, nv;
        if (n0 < 3584) { src = n0; nv = 64; }
        else if (n0 < 5632) { src = n0 + 16; nv = 64; }
        else if (n0 == 5632) { src = 3584; nv = 16; }
        else { src = 0; nv = 0; }
        tconv_tile(p.in[12], 5648, src, nv, kt * 64, WinT, 1024, n0, smem);
      }
    }
  }
  for (int tile = blockIdx.x; tile < 128; tile += gridDim.x) {
    int mt = tile & 1, nt = tile >> 1;
    f32x4 acc[4][4];
    zero_acc(acc);
    gemm_kloop(scb + (size_t)mt * 128 * 1024, 1024, WadaT + (size_t)nt * 128 * 1024, 1024, 1024, acc, smem);
    gemm_epilogue(acc, smem, mt * 128, nt * 128, [&](int row, int col, const float (&v)[8]) {
      if (row >= 136) return;
      if (col < 6144) {
        float* d = mod + (size_t)row * 6144 + col;
#pragma unroll
        for (int i = 0; i < 8; ++i) d[i] = v[i] + b_ada[col + i];
      } else {
        int c = col - 6144;
        float* d = modf + (size_t)row * 2048 + c;
#pragma unroll
        for (int i = 0; i < 8; ++i) d[i] = v[i] + b_adaf[c + i];
      }
    });
  }
}

__device__ void phase_norm(const P& p, int which) {
  const int lane = threadIdx.x & 63, wid = threadIdx.x >> 6;
  const float* mod = (const float*)(p.ws + OFF_MOD);
  const bf16_t* x1 = (const bf16_t*)(p.ws + OFF_XBC);
  bf16_t* hout = (bf16_t*)(p.ws + OFF_ACT);
  const float* g = which ? p.in[11] : p.in[10];
  for (int t = blockIdx.x * 4 + wid; t < TT; t += gridDim.x * 4) {
    const float* md = mod + (size_t)mrow(t) * 6144 + (which ? 3072 : 0);
    float v[16];
    if (which) {
      const bf16_t* xr = x1 + (size_t)t * 1024;
      uint4 a = *(const uint4*)(xr + lane * 8), c = *(const uint4*)(xr + 512 + lane * 8);
      float f0[8], f1[8];
      unpack8(a, f0); unpack8(c, f1);
#pragma unroll
      for (int i = 0; i < 8; ++i) { v[i] = f0[i]; v[8 + i] = f1[i]; }
    } else {
      const float* xr = (t < TP ? p.in[0] + (size_t)t * 1024 : p.in[1] + (size_t)(t - TP) * 1024);
      float4 a = *(const float4*)(xr + lane * 8), b = *(const float4*)(xr + lane * 8 + 4);
      float4 c = *(const float4*)(xr + 512 + lane * 8), d = *(const float4*)(xr + 512 + lane * 8 + 4);
      v[0] = a.x; v[1] = a.y; v[2] = a.z; v[3] = a.w; v[4] = b.x; v[5] = b.y; v[6] = b.z; v[7] = b.w;
      v[8] = c.x; v[9] = c.y; v[10] = c.z; v[11] = c.w; v[12] = d.x; v[13] = d.y; v[14] = d.z; v[15] = d.w;
    }
    float ss = 0.f;
#pragma unroll
    for (int i = 0; i < 16; ++i) ss += v[i] * v[i];
    ss = wave_sum(ss);
    float rs = rsqrtf(ss * (1.f / 1024.f) + 1e-6f);
#pragma unroll
    for (int hf = 0; hf < 2; ++hf) {
      int c0 = hf * 512 + lane * 8;
      float o[8];
#pragma unroll
      for (int i = 0; i < 8; ++i) {
        int c = c0 + i;
        o[i] = v[hf * 8 + i] * rs * g[c] * (1.f + md[1024 + c]) + md[c];
      }
      store8bf(hout + (size_t)t * 1024 + c0, o);
    }
  }
}

__device__ void phase_inproj(const P& p, char* smem) {
  const bf16_t* h = (const bf16_t*)(p.ws + OFF_ACT);
  const bf16_t* WinT = (const bf16_t*)(p.ws + OFF_WINT);
  bf16_t* u = (bf16_t*)(p.ws + OFF_U);
  bf16_t* z = (bf16_t*)(p.ws + OFF_Z);
  bf16_t* xbc = (bf16_t*)(p.ws + OFF_XBC);
  bf16_t* gates = (bf16_t*)(p.ws + OFF_GATES);
  float* dtb = (float*)(p.ws + OFF_DTB);
  const float* dt_bias = p.in[26];
  float* out = p.out;
  for (int tile = blockIdx.x; tile < 129 * 23; tile += gridDim.x) {
    const int mt = tile / 23, nt2 = tile % 23;
    f32x4 acc[4][8];
    zero_acc8(acc);
    gemm_kloop_n256(h + (size_t)mt * 128 * 1024, 1024, WinT + (size_t)nt2 * 256 * 1024, 1024, acc, smem);
    stage_all_bf16(acc, smem);
#pragma unroll 1
   for (int hh = 0; hh < 2; ++hh) {
    const int nt = nt2 * 2 + hh;
    if (nt >= 12 && nt < 28 && mt < 128) {
      const int tid = threadIdx.x;
      const bf16_t* Cs = (const bf16_t*)smem;
      const int c8 = (tid & 15) * 8;
      const int ch = nt * 128 - 1536 + c8;
      const int cc = hh * 128 + c8;
      const float* cw = p.in[24];
      const float* cbias = p.in[25];
      float wk[4][8], bias[8];
#pragma unroll
      for (int k = 0; k < 4; ++k) {
        float4 a = *(const float4*)(cw + k * 2048 + ch), b = *(const float4*)(cw + k * 2048 + ch + 4);
        wk[k][0] = a.x; wk[k][1] = a.y; wk[k][2] = a.z; wk[k][3] = a.w; wk[k][4] = b.x; wk[k][5] = b.y; wk[k][6] = b.z; wk[k][7] = b.w;
      }
      {
        float4 a = *(const float4*)(cbias + ch), b = *(const float4*)(cbias + ch + 4);
        bias[0] = a.x; bias[1] = a.y; bias[2] = a.z; bias[3] = a.w; bias[4] = b.x; bias[5] = b.y; bias[6] = b.z; bias[7] = b.w;
      }
      const bool seq_start = ((mt & 15) == 0);
      bf16_t* tails = (bf16_t*)(p.ws + OFF_TAILS);
#pragma unroll 1
      for (int i = 0; i < 8; ++i) {
        const int row = (tid >> 4) + 16 * i;
        const int grow = mt * 128 + row;
        float cur[8];
        cs16_load8(Cs, row, cc, cur);
        if (row >= 125) store8bf(tails + ((size_t)mt * 3 + (row - 125)) * 2048 + ch, cur);
        {
          const int l = grow & 2047;
          if (l >= 2045) {
            float* o = out + O_CONV_P + ((size_t)(grow >> 11) * 3 + (l - 2045)) * 2048 + ch;
            *(float4*)o = make_float4(cur[0], cur[1], cur[2], cur[3]);
            *(float4*)(o + 4) = make_float4(cur[4], cur[5], cur[6], cur[7]);
          }
        }
        if (row < 3 && !seq_start) {
          store8bf(xbc + (size_t)grow * 2048 + ch, cur);
        } else {
          float a[8];
#pragma unroll
          for (int q = 0; q < 8; ++q) a[q] = bias[q] + wk[3][q] * cur[q];
#pragma unroll
          for (int k = 0; k < 3; ++k) {
            const int rr = row - 3 + k;
            if (rr >= 0) {
              float pv[8];
              cs16_load8(Cs, rr, cc, pv);
#pragma unroll
              for (int q = 0; q < 8; ++q) a[q] += wk[k][q] * pv[q];
            }
          }
#pragma unroll
          for (int q = 0; q < 8; ++q) a[q] = siluf(a[q]);
          store8bf(xbc + (size_t)grow * 2048 + ch, a);
        }
      }
      continue;
    }
    epi_pass16(smem, hh, mt * 128, nt * 128, [&](int row, int col, const float (&v)[8]) {
      if (col < 512) {
        store8bf(u + (size_t)row * 512 + col, v);
      } else if (col < 1536) {
        store8bf(z + (size_t)row * 1024 + (col - 512), v);
      } else if (col < 3584) {
        int ch = col - 1536;
        store8bf(xbc + (size_t)row * 2048 + ch, v);
        float* o = nullptr;
        if (row >= TP) o = out + O_CONV_S + ((size_t)(row - TP) * 3 + 2) * 2048 + ch;
        else { int l = row & 2047; if (l >= 2045) o = out + O_CONV_P + ((size_t)(row >> 11) * 3 + (l - 2045)) * 2048 + ch; }
        if (o) { *(float4*)o = make_float4(v[0], v[1], v[2], v[3]); *(float4*)(o + 4) = make_float4(v[4], v[5], v[6], v[7]); }
      } else if (col < 5632) {
        float s[8];
#pragma unroll
        for (int i = 0; i < 8; ++i) s[i] = sigmf(v[i]);
        store8bf(gates + (size_t)row * 2048 + (col - 3584), s);
      } else if (col < 5648) {
#pragma unroll
        for (int i = 0; i < 8; ++i) {
          int hh = col - 5632 + i;
          float x = v[i] + dt_bias[hh];
          dtb[(size_t)row * 16 + hh] = (x > 20.f) ? x : log1pf(expf(x));
        }
      }
    });
   }
    __syncthreads();
  }
}

__device__ void phase_convfix(const P& p) {
  bf16_t* xbc = (bf16_t*)(p.ws + OFF_XBC);
  const bf16_t* tails = (const bf16_t*)(p.ws + OFF_TAILS);
  const float* cw = p.in[24];
  const float* cbias = p.in[25];
  const int ch = threadIdx.x * 8;
  for (int mt = blockIdx.x + 1; mt < 128; mt += gridDim.x) {
    if ((mt & 15) == 0) continue;
    float raw[6][8];
#pragma unroll
    for (int r = 0; r < 3; ++r) {
      uint4 a = *(const uint4*)(tails + ((size_t)(mt - 1) * 3 + r) * 2048 + ch);
      uint4 b = *(const uint4*)(xbc + ((size_t)mt * 128 + r) * 2048 + ch);
      unpack8(a, raw[r]); unpack8(b, raw[3 + r]);
    }
    float wk[4][8], bias[8];
#pragma unroll
    for (int k = 0; k < 4; ++k) {
      float4 a = *(const float4*)(cw + k * 2048 + ch), b = *(const float4*)(cw + k * 2048 + ch + 4);
      wk[k][0] = a.x; wk[k][1] = a.y; wk[k][2] = a.z; wk[k][3] = a.w; wk[k][4] = b.x; wk[k][5] = b.y; wk[k][6] = b.z; wk[k][7] = b.w;
    }
    {
      float4 a = *(const float4*)(cbias + ch), b = *(const float4*)(cbias + ch + 4);
      bias[0] = a.x; bias[1] = a.y; bias[2] = a.z; bias[3] = a.w; bias[4] = b.x; bias[5] = b.y; bias[6] = b.z; bias[7] = b.w;
    }
#pragma unroll
    for (int r = 0; r < 3; ++r) {
      float o[8];
#pragma unroll
      for (int q = 0; q < 8; ++q)
        o[q] = siluf(bias[q] + wk[0][q] * raw[r][q] + wk[1][q] * raw[r + 1][q] + wk[2][q] * raw[r + 2][q] + wk[3][q] * raw[r + 3][q]);
      store8bf(xbc + ((size_t)mt * 128 + r) * 2048 + ch, o);
    }
  }
}

__device__ void ssd_prompt_item(const P& p, char* smem, int b, int h) {
  const int tid = threadIdx.x, lane = tid & 63, w = tid >> 6, fr = lane & 15, fq = lane >> 4;
  const int g = h >> 2;
  bf16_t* Cm = (bf16_t*)(smem);
  bf16_t* Bm = (bf16_t*)(smem + 17408);
  bf16_t* Wb = Bm;
  bf16_t* BmT = (bf16_t*)(smem + 34816);
  bf16_t* XT = (bf16_t*)(smem + 53248);
  bf16_t* Hp = (bf16_t*)(smem + 62464);
  float* dts = (float*)(smem + 79872);
  float* css = (float*)(smem + 80128);
  const bf16_t* xbc = (const bf16_t*)(p.ws + OFF_XBC);
  const bf16_t* zb = (const bf16_t*)(p.ws + OFF_Z);
  const float* dtb = (const float*)(p.ws + OFF_DTB);
  bf16_t* yssd = (bf16_t*)(p.ws + OFF_YSSD);
  const float a_h = -expf(p.in[27][h]);
  const float Dh = p.in[28][h];
  for (int i = tid; i < 64 * 136 / 2; i += 256) ((unsigned*)Hp)[i] = 0u;
  f32x4 st[8];
#pragma unroll
  for (int n = 0; n < 8; ++n) st[n] = f32x4{0.f, 0.f, 0.f, 0.f};
  __syncthreads();
  const int xc4 = tid & 15, xj0 = (tid >> 4) * 4;
  const int bc4a = tid & 31, bj0a = (tid >> 5) * 4;
  const int bj0b = bj0a + 32;
  uint2 px[4], pb0[4], pb1[4], pc0[4], pc1[4];
  float pdt = 0.f;
  auto issue_loads = [&](int c) __attribute__((always_inline)) {
    const size_t r0 = (size_t)(b * 2048 + c * 64);
#pragma unroll
    for (int r = 0; r < 4; ++r) {
      px[r] = *(const uint2*)(xbc + (r0 + xj0 + r) * 2048 + h * 64 + xc4 * 4);
      pb0[r] = *(const uint2*)(xbc + (r0 + bj0a + r) * 2048 + 1024 + g * 128 + bc4a * 4);
      pb1[r] = *(const uint2*)(xbc + (r0 + bj0b + r) * 2048 + 1024 + g * 128 + bc4a * 4);
      pc0[r] = *(const uint2*)(xbc + (r0 + bj0a + r) * 2048 + 1536 + g * 128 + bc4a * 4);
      pc1[r] = *(const uint2*)(xbc + (r0 + bj0b + r) * 2048 + 1536 + g * 128 + bc4a * 4);
    }
    if (w == 0) pdt = dtb[(r0 + lane) * 16 + h];
  };
  issue_loads(0);
#pragma unroll 1
  for (int c = 0; c < 32; ++c) {
    const int t0 = b * 2048 + c * 64;
    if (w == 0) {
      float dt = pdt;
      float s = wave_incl_scan(dt * a_h);
      dts[lane] = dt;
      css[lane] = s;
    }
    __syncthreads();
    const float cs_last = css[63];
    {
      *(uint2*)(XT + (xc4 * 4 + 0) * 72 + xj0) = make_uint2((px[0].x & 0xffffu) | (px[1].x << 16), (px[2].x & 0xffffu) | (px[3].x << 16));
      *(uint2*)(XT + (xc4 * 4 + 1) * 72 + xj0) = make_uint2((px[0].x >> 16) | (px[1].x & 0xffff0000u), (px[2].x >> 16) | (px[3].x & 0xffff0000u));
      *(uint2*)(XT + (xc4 * 4 + 2) * 72 + xj0) = make_uint2((px[0].y & 0xffffu) | (px[1].y << 16), (px[2].y & 0xffffu) | (px[3].y << 16));
      *(uint2*)(XT + (xc4 * 4 + 3) * 72 + xj0) = make_uint2((px[0].y >> 16) | (px[1].y & 0xffff0000u), (px[2].y >> 16) | (px[3].y & 0xffff0000u));
#pragma unroll
      for (int r = 0; r < 4; ++r) {
        *(uint2*)(Bm + (bj0a + r) * 136 + bc4a * 4) = pb0[r];
        *(uint2*)(Bm + (bj0b + r) * 136 + bc4a * 4) = pb1[r];
        *(uint2*)(Cm + (bj0a + r) * 136 + bc4a * 4) = pc0[r];
        *(uint2*)(Cm + (bj0b + r) * 136 + bc4a * 4) = pc1[r];
      }
      float sa[4], sb[4];
#pragma unroll
      for (int r = 0; r < 4; ++r) {
        sa[r] = dts[bj0a + r] * __expf(cs_last - css[bj0a + r]);
        sb[r] = dts[bj0b + r] * __expf(cs_last - css[bj0b + r]);
      }
      *(uint2*)(BmT + (bc4a * 4 + 0) * 72 + bj0a) = make_uint2(cvtpk(bflo(pb0[0].x) * sa[0], bflo(pb0[1].x) * sa[1]), cvtpk(bflo(pb0[2].x) * sa[2], bflo(pb0[3].x) * sa[3]));
      *(uint2*)(BmT + (bc4a * 4 + 1) * 72 + bj0a) = make_uint2(cvtpk(bfhi(pb0[0].x) * sa[0], bfhi(pb0[1].x) * sa[1]), cvtpk(bfhi(pb0[2].x) * sa[2], bfhi(pb0[3].x) * sa[3]));
      *(uint2*)(BmT + (bc4a * 4 + 2) * 72 + bj0a) = make_uint2(cvtpk(bflo(pb0[0].y) * sa[0], bflo(pb0[1].y) * sa[1]), cvtpk(bflo(pb0[2].y) * sa[2], bflo(pb0[3].y) * sa[3]));
      *(uint2*)(BmT + (bc4a * 4 + 3) * 72 + bj0a) = make_uint2(cvtpk(bfhi(pb0[0].y) * sa[0], bfhi(pb0[1].y) * sa[1]), cvtpk(bfhi(pb0[2].y) * sa[2], bfhi(pb0[3].y) * sa[3]));
      *(uint2*)(BmT + (bc4a * 4 + 0) * 72 + bj0b) = make_uint2(cvtpk(bflo(pb1[0].x) * sb[0], bflo(pb1[1].x) * sb[1]), cvtpk(bflo(pb1[2].x) * sb[2], bflo(pb1[3].x) * sb[3]));
      *(uint2*)(BmT + (bc4a * 4 + 1) * 72 + bj0b) = make_uint2(cvtpk(bfhi(pb1[0].x) * sb[0], bfhi(pb1[1].x) * sb[1]), cvtpk(bfhi(pb1[2].x) * sb[2], bfhi(pb1[3].x) * sb[3]));
      *(uint2*)(BmT + (bc4a * 4 + 2) * 72 + bj0b) = make_uint2(cvtpk(bflo(pb1[0].y) * sb[0], bflo(pb1[1].y) * sb[1]), cvtpk(bflo(pb1[2].y) * sb[2], bflo(pb1[3].y) * sb[3]));
      *(uint2*)(BmT + (bc4a * 4 + 3) * 72 + bj0b) = make_uint2(cvtpk(bfhi(pb1[0].y) * sb[0], bfhi(pb1[1].y) * sb[1]), cvtpk(bfhi(pb1[2].y) * sb[2], bfhi(pb1[3].y) * sb[3]));
    }
    if (c + 1 < 32) issue_loads(c + 1);
    __syncthreads();
    f32x4 cbv[4];
#pragma unroll
    for (int jt = 0; jt < 4; ++jt) cbv[jt] = f32x4{0.f, 0.f, 0.f, 0.f};
#pragma unroll
    for (int ks = 0; ks < 4; ++ks) {
      bf16x8 a = *(const bf16x8*)(Cm + (16 * w + fr) * 136 + ks * 32 + fq * 8);
#pragma unroll
      for (int jt = 0; jt < 4; ++jt) {
        bf16x8 bb = *(const bf16x8*)(Bm + (jt * 16 + fr) * 136 + ks * 32 + fq * 8);
        cbv[jt] = __builtin_amdgcn_mfma_f32_16x16x32_bf16(a, bb, cbv[jt], 0, 0, 0);
      }
    }
    __syncthreads();
#pragma unroll
    for (int jt = 0; jt < 4; ++jt)
#pragma unroll
      for (int r = 0; r < 4; ++r) {
        int i = 16 * w + 4 * fq + r, j = jt * 16 + fr;
        float val = 0.f;
        if (j <= i) val = cbv[jt][r] * __expf(css[i] - css[j]) * dts[j];
        Wb[i * 72 + j] = f2bf(val);
      }
    __syncthreads();
    {
      f32x4 yd[4], yo[4];
#pragma unroll
      for (int mt = 0; mt < 4; ++mt) { yd[mt] = f32x4{0.f, 0.f, 0.f, 0.f}; yo[mt] = f32x4{0.f, 0.f, 0.f, 0.f}; }
#pragma unroll
      for (int ks = 0; ks < 2; ++ks) {
        bf16x8 bb = *(const bf16x8*)(XT + (16 * w + fr) * 72 + ks * 32 + fq * 8);
#pragma unroll
        for (int mt = 0; mt < 4; ++mt) {
          bf16x8 a = *(const bf16x8*)(Wb + (mt * 16 + fr) * 72 + ks * 32 + fq * 8);
          yd[mt] = __builtin_amdgcn_mfma_f32_16x16x32_bf16(a, bb, yd[mt], 0, 0, 0);
        }
      }
#pragma unroll
      for (int ks = 0; ks < 4; ++ks) {
        bf16x8 bb = *(const bf16x8*)(Hp + (16 * w + fr) * 136 + ks * 32 + fq * 8);
#pragma unroll
        for (int mt = 0; mt < 4; ++mt) {
          bf16x8 a = *(const bf16x8*)(Cm + (mt * 16 + fr) * 136 + ks * 32 + fq * 8);
          yo[mt] = __builtin_amdgcn_mfma_f32_16x16x32_bf16(a, bb, yo[mt], 0, 0, 0);
        }
      }
      const int pp = 16 * w + fr;
#pragma unroll
      for (int mt = 0; mt < 4; ++mt)
#pragma unroll
        for (int r = 0; r < 4; ++r) {
          int i = mt * 16 + 4 * fq + r;
          float yv = yd[mt][r] + __expf(css[i]) * yo[mt][r] + Dh * bf2f(XT[pp * 72 + i]);
          size_t off = (size_t)(t0 + i) * 1024 + h * 64 + pp;
          yssd[off] = f2bf(yv);
        }
    }
    {
      const float dec = __expf(cs_last);
#pragma unroll
      for (int n = 0; n < 8; ++n) { st[n][0] *= dec; st[n][1] *= dec; st[n][2] *= dec; st[n][3] *= dec; }
#pragma unroll
      for (int ks = 0; ks < 2; ++ks) {
        bf16x8 a = *(const bf16x8*)(XT + (16 * w + fr) * 72 + ks * 32 + fq * 8);
#pragma unroll
        for (int n = 0; n < 8; ++n) {
          bf16x8 bb = *(const bf16x8*)(BmT + (n * 16 + fr) * 72 + ks * 32 + fq * 8);
          st[n] = __builtin_amdgcn_mfma_f32_16x16x32_bf16(a, bb, st[n], 0, 0, 0);
        }
      }
#pragma unroll
      for (int n = 0; n < 8; ++n)
#pragma unroll
        for (int r = 0; r < 4; ++r) Hp[(16 * w + 4 * fq + r) * 136 + n * 16 + fr] = f2bf(st[n][r]);
    }
    __syncthreads();
  }
  float* so = p.out + O_SSM_P + ((size_t)(b * 16 + h) * 64) * 128;
#pragma unroll
  for (int n = 0; n < 8; ++n)
#pragma unroll
    for (int r = 0; r < 4; ++r) so[(size_t)(16 * w + 4 * fq + r) * 128 + n * 16 + fr] = st[n][r];
}

struct S5Par { float ar, ai; };
DI void s5_abar(const P& p, int g, int pp, float& abr, float& abi, float& fre, float& fim) {
  float dt = expf(p.in[15][g]);
  float ar = p.in[13][g * 64 + pp], ai = p.in[14][g * 64 + pp];
  float mag = expf(dt * ar);
  float sn, cs;
  sincosf(dt * ai, &sn, &cs);
  abr = mag * cs; abi = mag * sn;
  float den = ar * ar + ai * ai;
  float nr = abr - 1.f;
  fre = (nr * ar + abi * ai) / den;
  fim = (abi * ar - nr * ai) / den;
}

__device__ void s5_prompt_item(const P& p, char* smem, int b, int g4) {
  const int tid = threadIdx.x, lane = tid & 63, w = tid >> 6;
  const int g = g4 * 4 + w;
  const int r31 = lane & 31, hh = lane >> 5, fr = lane & 15, fq = lane >> 4;
  bf16_t* Sl = (bf16_t*)(smem + w * 8704);
  const bf16_t* ub = (const bf16_t*)(p.ws + OFF_U);
  bf16_t* ys5 = (bf16_t*)(p.ws + OFF_YS5);
  float a1r[2], a1i[2], a2r[2], a2i[2], a3r[2], a3i[2], a4r[2], a4i[2];
  bf16x8 bfrag[4];
#pragma unroll
  for (int pi = 0; pi < 2; ++pi) {
    int pp = pi * 32 + r31;
    float fre, fim;
    s5_abar(p, g, pp, a1r[pi], a1i[pi], fre, fim);
    a2r[pi] = a1r[pi] * a1r[pi] - a1i[pi] * a1i[pi]; a2i[pi] = 2.f * a1r[pi] * a1i[pi];
    a3r[pi] = a2r[pi] * a1r[pi] - a2i[pi] * a1i[pi]; a3i[pi] = a2r[pi] * a1i[pi] + a2i[pi] * a1r[pi];
    a4r[pi] = a2r[pi] * a2r[pi] - a2i[pi] * a2i[pi]; a4i[pi] = 2.f * a2r[pi] * a2i[pi];
    const float* br = p.in[16] + ((size_t)(g * 64 + pp)) * 16 + hh * 8;
    const float* bi = p.in[17] + ((size_t)(g * 64 + pp)) * 16 + hh * 8;
    float vr[8], vi[8];
#pragma unroll
    for (int j = 0; j < 8; ++j) {
      vr[j] = fre * br[j] - fim * bi[j];
      vi[j] = fre * bi[j] + fim * br[j];
    }
    bfrag[pi] = mk8(cvtpk(vr[0], vr[1]), cvtpk(vr[2], vr[3]), cvtpk(vr[4], vr[5]), cvtpk(vr[6], vr[7]));
    bfrag[2 + pi] = mk8(cvtpk(vi[0], vi[1]), cvtpk(vi[2], vi[3]), cvtpk(vi[4], vi[5]), cvtpk(vi[6], vi[7]));
  }
  bf16x8 cfrag[4];
#pragma unroll
  for (int ks = 0; ks < 4; ++ks) {
    int k0 = 32 * ks + 8 * fq;
    float v[8];
#pragma unroll
    for (int j = 0; j < 8; ++j) {
      int k = k0 + j;
      v[j] = (k < 64) ? p.in[18][((size_t)(g * 16 + fr)) * 64 + k] : -p.in[19][((size_t)(g * 16 + fr)) * 64 + (k - 64)];
    }
    cfrag[ks] = mk8(cvtpk(v[0], v[1]), cvtpk(v[2], v[3]), cvtpk(v[4], v[5]), cvtpk(v[6], v[7]));
  }
  const float dsk = p.in[20][g * 16 + fr];
  float Sr[2] = {0.f, 0.f}, Si[2] = {0.f, 0.f};
  const size_t tbase = (size_t)b * 2048;
  bf16x8 afr_n = *(const bf16x8*)(ub + (tbase + r31) * 512 + g * 16 + hh * 8);
  bf16_t uv_n[8];
#pragma unroll
  for (int q = 0; q < 8; ++q) uv_n[q] = ub[(tbase + (q >> 2) * 16 + 4 * fq + (q & 3)) * 512 + g * 16 + fr];
#pragma unroll 1
  for (int c = 0; c < 64; ++c) {
    const size_t t0 = tbase + c * 32;
    const bf16x8 afr = afr_n;
    bf16_t uv_c[8];
#pragma unroll
    for (int q = 0; q < 8; ++q) uv_c[q] = uv_n[q];
    if (c + 1 < 64) {
      afr_n = *(const bf16x8*)(ub + (t0 + 32 + r31) * 512 + g * 16 + hh * 8);
#pragma unroll
      for (int q = 0; q < 8; ++q) uv_n[q] = ub[(t0 + 32 + (q >> 2) * 16 + 4 * fq + (q & 3)) * 512 + g * 16 + fr];
    }
    f32x16 acc[4];
#pragma unroll
    for (int ct = 0; ct < 4; ++ct) {
#pragma unroll
      for (int q = 0; q < 16; ++q) acc[ct][q] = 0.f;
      acc[ct] = __builtin_amdgcn_mfma_f32_32x32x16_bf16(afr, bfrag[ct], acc[ct], 0, 0, 0);
    }
#pragma unroll
    for (int pi = 0; pi < 2; ++pi) {
      float sre[16], sim[16];
#pragma unroll
      for (int q = 0; q < 16; ++q) { sre[q] = acc[pi][q]; sim[q] = acc[2 + pi][q]; }
#pragma unroll
      for (int k = 0; k < 4; ++k)
#pragma unroll
        for (int i = 1; i < 4; ++i) {
          int q = 4 * k + i;
          float nr = sre[q] + a1r[pi] * sre[q - 1] - a1i[pi] * sim[q - 1];
          float ni = sim[q] + a1r[pi] * sim[q - 1] + a1i[pi] * sre[q - 1];
          sre[q] = nr; sim[q] = ni;
        }
      float Pr[4], Pi[4];
#pragma unroll
      for (int k = 0; k < 4; ++k) { Pr[k] = __shfl_xor(sre[4 * k + 3], 32); Pi[k] = __shfl_xor(sim[4 * k + 3], 32); }
      float cr = Sr[pi], ci = Si[pi];
      float cinr[4], cini[4];
#pragma unroll
      for (int G = 0; G < 8; ++G) {
        const int k = G >> 1;
        const bool mine = ((G & 1) == hh);
        if ((G & 1) == 0) { cinr[k] = cr; cini[k] = ci; }
        else { cinr[k] = mine ? cr : cinr[k]; cini[k] = mine ? ci : cini[k]; }
        float fr_ = mine ? sre[4 * k + 3] : Pr[k];
        float fi_ = mine ? sim[4 * k + 3] : Pi[k];
        float nr = a4r[pi] * cr - a4i[pi] * ci + fr_;
        float ni = a4r[pi] * ci + a4i[pi] * cr + fi_;
        cr = nr; ci = ni;
      }
      Sr[pi] = cr; Si[pi] = ci;
#pragma unroll
      for (int k = 0; k < 4; ++k) {
        const float pwr[4] = {a1r[pi], a2r[pi], a3r[pi], a4r[pi]};
        const float pwi[4] = {a1i[pi], a2i[pi], a3i[pi], a4i[pi]};
#pragma unroll
        for (int i = 0; i < 4; ++i) {
          int q = 4 * k + i;
          float vr = sre[q] + pwr[i] * cinr[k] - pwi[i] * cini[k];
          float vi = sim[q] + pwr[i] * cini[k] + pwi[i] * cinr[k];
          int tok = i + 8 * k + 4 * hh;
          Sl[tok * 136 + pi * 32 + r31] = f2bf(vr);
          Sl[tok * 136 + 64 + pi * 32 + r31] = f2bf(vi);
        }
      }
    }
    __syncthreads();
    f32x4 yacc[2];
#pragma unroll
    for (int mt = 0; mt < 2; ++mt) {
      yacc[mt] = f32x4{0.f, 0.f, 0.f, 0.f};
#pragma unroll
      for (int ks = 0; ks < 4; ++ks) {
        bf16x8 a = *(const bf16x8*)(Sl + (mt * 16 + fr) * 136 + ks * 32 + fq * 8);
        yacc[mt] = __builtin_amdgcn_mfma_f32_16x16x32_bf16(a, cfrag[ks], yacc[mt], 0, 0, 0);
      }
    }
#pragma unroll
    for (int mt = 0; mt < 2; ++mt)
#pragma unroll
      for (int r = 0; r < 4; ++r) {
        int tok = mt * 16 + 4 * fq + r;
        size_t off = (t0 + tok) * 512 + g * 16 + fr;
        float uv = bf2f(uv_c[mt * 4 + r]);
        ys5[off] = f2bf(geluf(yacc[mt][r] + dsk * uv));
      }
    __syncthreads();
  }
  if (hh == 0) {
#pragma unroll
    for (int pi = 0; pi < 2; ++pi) {
      p.out[O_S5RE_P + (size_t)(b * 32 + g) * 64 + pi * 32 + r31] = Sr[pi];
      p.out[O_S5IM_P + (size_t)(b * 32 + g) * 64 + pi * 32 + r31] = Si[pi];
    }
  }
}

__device__ void s5_sample_item(const P& p, int item) {
  const int lane = threadIdx.x & 63, w = threadIdx.x >> 6;
  const bf16_t* ub = (const bf16_t*)(p.ws + OFF_U);
  bf16_t* ys5 = (bf16_t*)(p.ws + OFF_YS5);
  const int b = item >> 3;
  const int g = (item & 7) * 4 + w;
  const size_t t = TP + b;
  float abr, abi, fre, fim;
  s5_abar(p, g, lane, abr, abi, fre, fim);
  float uv[16];
  {
    uint4 u0 = *(const uint4*)(ub + t * 512 + g * 16), u1 = *(const uint4*)(ub + t * 512 + g * 16 + 8);
    float t0[8], t1[8];
    unpack8(u0, t0); unpack8(u1, t1);
#pragma unroll
    for (int i = 0; i < 8; ++i) { uv[i] = t0[i]; uv[8 + i] = t1[i]; }
  }
  float cr[16], cm[16], dsk[16];
#pragma unroll
  for (int hx = 0; hx < 16; ++hx) {
    cr[hx] = p.in[18][((size_t)(g * 16 + hx)) * 64 + lane];
    cm[hx] = p.in[19][((size_t)(g * 16 + hx)) * 64 + lane];
    dsk[hx] = p.in[20][g * 16 + hx];
  }
  const float* br = p.in[16] + ((size_t)(g * 64 + lane)) * 16;
  const float* bi = p.in[17] + ((size_t)(g * 64 + lane)) * 16;
  float bur = 0.f, bui = 0.f;
#pragma unroll
  for (int hx = 0; hx < 16; ++hx) {
    float bbr = fre * br[hx] - fim * bi[hx];
    float bbi = fre * bi[hx] + fim * br[hx];
    bur += bbr * uv[hx]; bui += bbi * uv[hx];
  }
  float s0r = p.in[2][((size_t)b * 32 + g) * 64 + lane], s0i = p.in[3][((size_t)b * 32 + g) * 64 + lane];
  float sr = abr * s0r - abi * s0i + bur;
  float si = abr * s0i + abi * s0r + bui;
  p.out[O_S5RE_S + ((size_t)b * 32 + g) * 64 + lane] = sr;
  p.out[O_S5IM_S + ((size_t)b * 32 + g) * 64 + lane] = si;
  float myy = 0.f;
#pragma unroll
  for (int hx = 0; hx < 16; ++hx) {
    float v = wave_sum_fast(cr[hx] * sr - cm[hx] * si);
    if (lane == hx) myy = v + dsk[hx] * uv[hx];
  }
  if (lane < 16) ys5[t * 512 + g * 16 + lane] = f2bf(geluf(myy));
}

__device__ void ssd_sample_item(const P& p, char* smem, int b, int g) {
  const int tid = threadIdx.x, lane = tid & 63, w = tid >> 6;
  float* xs = (float*)smem;
  float* Bs = xs + 256;
  float* Cs = Bs + 128;
  float* ybuf = Cs + 128;
  float* red = ybuf + 256;
  const size_t t = TP + b;
  const bf16_t* xbc = (const bf16_t*)(p.ws + OFF_XBC);
  const bf16_t* zb = (const bf16_t*)(p.ws + OFF_Z);
  const float* dtb = (const float*)(p.ws + OFF_DTB);
  bf16_t* yb = (bf16_t*)(p.ws + OFF_YSSD);
  const float* cw = p.in[24];
  const float* cbias = p.in[25];
  const float* sconv = p.in[5] + (size_t)b * 3 * 2048;
  {
#pragma unroll
    for (int part = 0; part < 2; ++part) {
      int ch = part == 0 ? (g * 256 + tid) : (tid < 128 ? 1024 + g * 128 + tid : 1536 + g * 128 + (tid - 128));
      float a = cbias[ch] + cw[ch] * sconv[ch] + cw[2048 + ch] * sconv[2048 + ch] + cw[4096 + ch] * sconv[4096 + ch]
                + cw[6144 + ch] * bf2f(xbc[t * 2048 + ch]);
      a = siluf(a);
      if (part == 0) xs[tid] = a; else Bs[tid] = a;
    }
  }
  __syncthreads();
  const int h = g * 4 + w;
  const float dt = dtb[t * 16 + h];
  const float a_h = -expf(p.in[27][h]);
  const float dA = __expf(dt * a_h);
  const float* h0 = p.in[4] + ((size_t)(b * 16 + h) * 64) * 128;
  float* hn = p.out + O_SSM_S + ((size_t)(b * 16 + h) * 64) * 128;
  const int n4 = (lane & 31) * 4;
  const float4 Bv = *(const float4*)(Bs + n4);
  const float4 Cv = *(const float4*)(Cs + n4);
#pragma unroll 4
  for (int it = 0; it < 32; ++it) {
    int pp = 2 * it + (lane >> 5);
    float4 hv = *(const float4*)(h0 + (size_t)pp * 128 + n4);
    float xd = dt * xs[w * 64 + pp];
    float4 nv;
    nv.x = dA * hv.x + xd * Bv.x; nv.y = dA * hv.y + xd * Bv.y; nv.z = dA * hv.z + xd * Bv.z; nv.w = dA * hv.w + xd * Bv.w;
    *(float4*)(hn + (size_t)pp * 128 + n4) = nv;
    float part = Cv.x * nv.x + Cv.y * nv.y + Cv.z * nv.z + Cv.w * nv.w;
#pragma unroll
    for (int o = 16; o; o >>= 1) part += __shfl_xor(part, o);
    if ((lane & 31) == 0) ybuf[w * 64 + pp] = part;
  }
  __syncthreads();
  float y = ybuf[tid] + p.in[28][g * 4 + (tid >> 6)] * xs[tid];
  float zv = bf2f(zb[t * 1024 + g * 256 + tid]);
  y *= siluf(zv);
  float ss = wave_sum(y * y);
  if (lane == 0) red[w] = ss;
  __syncthreads();
  float tot = red[0] + red[1] + red[2] + red[3];
  float rs = rsqrtf(tot * (1.f / 256.f) + 1e-5f);
  yb[t * 1024 + g * 256 + tid] = f2bf(y * rs * p.in[29][g * 256 + tid]);
  __syncthreads();
}

__device__ void expert_convert_dynamic(const P& p, char* smem) {
  unsigned char* E8 = (unsigned char*)(p.ws + OFF_E8);
  float* Esc = (float*)(p.ws + OFF_E8 + 33554432);
  unsigned* counter = (unsigned*)(p.ws + OFF_BAR + 14336);
  const int tid = threadIdx.x, lane = tid & 63, wid = tid >> 6;
  int* stask = (int*)(smem + 64);
  for (;;) {
    __syncthreads();
    if (tid == 0) *stask = (int)atomicAdd(counter, 1u);
    __syncthreads();
    const int q = *stask;
    if (q >= 2048) break;
    const int tbl = (q >= 1024) ? 1 : 0;
    const float* src = tbl ? p.in[35] : p.in[34];
    const int row0 = (q & 1023) * 16 + wid * 4;
    float4 ld[4][4];
#pragma unroll
    for (int r = 0; r < 4; ++r) {
      const float* sp = src + (size_t)(row0 + r) * 1024 + lane * 16;
#pragma unroll
      for (int k = 0; k < 4; ++k) ld[r][k] = *(const float4*)(sp + 4 * k);
    }
#pragma unroll
    for (int r = 0; r < 4; ++r) {
      float am = 0.f;
#pragma unroll
      for (int k = 0; k < 4; ++k)
        am = fmaxf(am, fmaxf(fmaxf(fabsf(ld[r][k].x), fabsf(ld[r][k].y)), fmaxf(fabsf(ld[r][k].z), fabsf(ld[r][k].w))));
      am = wave_max(am);
      const float sc = (am > 0.f) ? am * (1.f / 448.f) : 1.f;
      const float inv = 1.f / sc;
      unsigned w[4];
#pragma unroll
      for (int k = 0; k < 4; ++k) {
        int t0 = __builtin_amdgcn_cvt_pk_fp8_f32(ld[r][k].x * inv, ld[r][k].y * inv, 0, false);
        t0 = __builtin_amdgcn_cvt_pk_fp8_f32(ld[r][k].z * inv, ld[r][k].w * inv, t0, true);
        w[k] = (unsigned)t0;
      }
      const int rowi = row0 + r;
      *(uint4*)(E8 + (size_t)tbl * 16777216 + (size_t)rowi * 1024 + lane * 16) = make_uint4(w[0], w[1], w[2], w[3]);
      if (lane == 0) Esc[tbl * 16384 + rowi] = sc;
    }
  }
  __syncthreads();
}

__device__ void late_weight_convert(const P& p, char* smem) {
  bf16_t* WgluT = (bf16_t*)(p.ws + OFF_WGLUT);
  bf16_t* WaT = (bf16_t*)(p.ws + OFF_WAT);
  bf16_t* WbT = (bf16_t*)(p.ws + OFF_WBT);
  bf16_t* WoutT = (bf16_t*)(p.ws + OFF_WOUTT);
  bf16_t* WqT = (bf16_t*)(p.ws + OFF_WQT);
  unsigned* counter = (unsigned*)(p.ws + OFF_BAR + 14400);
  int* stask = (int*)(smem + 20480);
  for (;;) {
    __syncthreads();
    if (threadIdx.x == 0) *stask = (int)atomicAdd(counter, 1u);
    __syncthreads();
    int t = *stask;
    if (t >= 1216) break;
    if (t < 64) { int nt = t >> 3, kt = t & 7; tconv_tile(p.in[21], 512, nt * 64, 64, kt * 64, WgluT, 512, nt * 64, smem); continue; }
    t -= 64;
    if (t < 128) { int nt = t >> 3, kt = t & 7; tconv_tile(p.in[23], 1024, nt * 64, 64, kt * 64, WaT, 512, nt * 64, smem); continue; }
    t -= 128;
    if (t < 256) { int nt = t >> 4, kt = t & 15; tconv_tile(p.in[30], 1024, nt * 64, 64, kt * 64, WbT, 1024, nt * 64, smem); continue; }
    t -= 256;
    if (t < 256) { int nt = t >> 4, kt = t & 15; tconv_tile(p.in[31], 1024, nt * 64, 64, kt * 64, WoutT, 1024, nt * 64, smem); continue; }
    t -= 256;
    { int nt = t >> 4, kt = t & 15; tconv_tile(p.in[32], 2048, nt * 64, 64, kt * 64, WqT, 1024, nt * 64, smem); }
  }
  __syncthreads();
}

__device__ void phase_mixers(const P& p, char* smem) {
  const int G = gridDim.x;
#pragma unroll 1
  for (int it = blockIdx.x; it < 128; it += G) { ssd_prompt_item(p, smem, it >> 4, it & 15); __syncthreads(); }
#pragma unroll 1
  for (int it = (blockIdx.x + G - 128 % G) % G; it < 64; it += G) { s5_prompt_item(p, smem, it >> 3, it & 7); __syncthreads(); }
  const bool wide = (G >= 512);
  const int bid = (int)blockIdx.x;
  const int wi = (bid >= 192 && bid < 256) ? bid - 192 : ((bid >= 384) ? bid - 384 + 64 : -1);
  const int nw = G - 320;
  const int ss_start = wide ? (wi >= 0 ? wi : 512) : (int)((blockIdx.x + G - 192 % G) % G);
  const int ss_step = wide ? nw : G;
#pragma unroll 1
  for (int it = ss_start; it < 512; it += ss_step) { ssd_sample_item(p, smem, it >> 2, it & 3); __syncthreads(); }
  const int s5s_start = wide ? (wi >= 0 ? wi : 1024) : (int)((blockIdx.x + G - 704 % G) % G);
#pragma unroll 1
  for (int it = s5s_start; it < 1024; it += ss_step) { s5_sample_item(p, it); __syncthreads(); }
  if (wide && bid >= 256 && bid < 384) return;
  late_weight_convert(p, smem);
  expert_convert_dynamic(p, smem);
}

__device__ void phase_glu(const P& p, char* smem) {
  const bf16_t* ys5 = (const bf16_t*)(p.ws + OFF_YS5);
  const bf16_t* WgluT = (const bf16_t*)(p.ws + OFF_WGLUT);
  bf16_t* ya = (bf16_t*)(p.ws + OFF_U);
  bf16_t* yb = (bf16_t*)(p.ws + OFF_YSSD);
  const bf16_t* zb = (const bf16_t*)(p.ws + OFF_Z);
  const float* bglu = p.in[22];
  const float* gn = p.in[29];
  const int lane = threadIdx.x & 63, wid = threadIdx.x >> 6;
  const int NT = 516 + 1024;
  const int G = gridDim.x;
  const int nextra = (G >= 512 && G < 516) ? 516 - G : 0;
  for (int k = 0;; ++k) {
    int task;
    if (nextra == 0) { task = (int)blockIdx.x + k * G; if (task >= NT) break; }
    else {
      const int b = (int)blockIdx.x;
      if (k == 0) task = b;
      else if (b < nextra) { if (k == 1) task = G + b; else break; }
      else { const int nt_ = (b - nextra) + (k - 1) * (G - nextra); if (nt_ >= 1024) break; task = 516 + nt_; }
    }
    if (task < 516) {
      int mt = task >> 2, nt = task & 3;
      f32x4 acc[4][4];
      zero_acc(acc);
      gemm_kloop(ys5 + (size_t)mt * 128 * 512, 512, WgluT + (size_t)nt * 128 * 512, 512, 512, acc, smem);
      gemm_epilogue(acc, smem, mt * 128, nt * 128, [&](int row, int col, const float (&v)[8]) {
        uint4 yv = *(const uint4*)(ys5 + (size_t)row * 512 + col);
        float y[8], o[8];
        unpack8(yv, y);
#pragma unroll
        for (int i = 0; i < 8; ++i) o[i] = y[i] * sigmf(v[i] + bglu[col + i]);
        store8bf(ya + (size_t)row * 512 + col, o);
      });
    } else {
      int base = (task - 516) * 16;
#pragma unroll 1
      for (int q = 0; q < 4; ++q) {
        size_t t = base + q * 4 + wid;
        bf16_t* rowp = yb + t * 1024 + lane * 16;
        const bf16_t* zp = zb + t * 1024 + lane * 16;
        uint4 a = *(const uint4*)rowp, b = *(const uint4*)(rowp + 8);
        uint4 za = *(const uint4*)zp, zb2 = *(const uint4*)(zp + 8);
        float v0[8], v1[8], z0[8], z1[8];
        unpack8(a, v0); unpack8(b, v1); unpack8(za, z0); unpack8(zb2, z1);
#pragma unroll
        for (int i = 0; i < 8; ++i) { v0[i] *= siluf(z0[i]); v1[i] *= siluf(z1[i]); }
        float ss = 0.f;
#pragma unroll
        for (int i = 0; i < 8; ++i) ss += v0[i] * v0[i] + v1[i] * v1[i];
#pragma unroll
        for (int o = 8; o; o >>= 1) ss += __shfl_xor(ss, o);
        float rs = rsqrtf(ss * (1.f / 256.f) + 1e-5f);
        const float* gp = gn + lane * 16;
#pragma unroll
        for (int i = 0; i < 8; ++i) { v0[i] *= rs * gp[i]; v1[i] *= rs * gp[8 + i]; }
        store8bf(rowp, v0);
        store8bf(rowp + 8, v1);
      }
    }
  }
}

__device__ void phase_merge(const P& p, char* smem) {
  const bf16_t* ya = (const bf16_t*)(p.ws + OFF_U);
  const bf16_t* yb = (const bf16_t*)(p.ws + OFF_YSSD);
  const bf16_t* WaT = (const bf16_t*)(p.ws + OFF_WAT);
  const bf16_t* WbT = (const bf16_t*)(p.ws + OFF_WBT);
  const bf16_t* gates = (const bf16_t*)(p.ws + OFF_GATES);
  bf16_t* tmp = (bf16_t*)(p.ws + OFF_XBC);
  bf16_t* merged = (bf16_t*)(p.ws + OFF_ACT);
  auto epiA = [&](int row, int col, const float (&v)[8]) {
    uint4 gv = *(const uint4*)(gates + (size_t)row * 2048 + col);
    float gg[8];
    unpack8(gv, gg);
    float o[8];
#pragma unroll
    for (int i = 0; i < 8; ++i) o[i] = gg[i] * v[i];
    store8bf(tmp + (size_t)row * 1024 + col, o);
  };
  auto epiB = [&](int row, int col, const float (&v)[8]) {
    uint4 gv = *(const uint4*)(gates + (size_t)row * 2048 + 1024 + col);
    float gg[8], o[8];
    unpack8(gv, gg);
    uint4 tv = *(const uint4*)(tmp + (size_t)row * 1024 + col);
    float tf[8];
    unpack8(tv, tf);
#pragma unroll
    for (int i = 0; i < 8; ++i) o[i] = tf[i] + gg[i] * v[i];
    store8bf(merged + (size_t)row * 1024 + col, o);
  };
#pragma unroll 1
  for (int tile = blockIdx.x; tile < 512; tile += gridDim.x) {
    const int mt = tile >> 2, nt2 = tile & 3;
    f32x4 acc[4][8];
    zero_acc8(acc);
    gemm_kloop_n256(ya + (size_t)mt * 128 * 512, 512, WaT + (size_t)nt2 * 256 * 512, 512, acc, smem);
    stage_all_bf16(acc, smem);
#pragma unroll 1
    for (int hh = 0; hh < 2; ++hh) epi_pass16(smem, hh, mt * 128, (nt2 * 2 + hh) * 128, epiA);
    __syncthreads();
  }
#pragma unroll 1
  for (int nt = blockIdx.x; nt < 8; nt += gridDim.x) {
    f32x4 acc[4][4];
    zero_acc(acc);
    gemm_kloop(ya + (size_t)TP * 512, 512, WaT + (size_t)nt * 128 * 512, 512, 512, acc, smem);
    gemm_epilogue(acc, smem, TP, nt * 128, epiA);
  }
#pragma unroll 1
  for (int tile = blockIdx.x; tile < 512; tile += gridDim.x) {
    const int mt = tile >> 2, nt2 = tile & 3;
    f32x4 acc[4][8];
    zero_acc8(acc);
    gemm_kloop_n256(yb + (size_t)mt * 128 * 1024, 1024, WbT + (size_t)nt2 * 256 * 1024, 1024, acc, smem);
    stage_all_bf16(acc, smem);
#pragma unroll 1
    for (int hh = 0; hh < 2; ++hh) epi_pass16(smem, hh, mt * 128, (nt2 * 2 + hh) * 128, epiB);
    __syncthreads();
  }
#pragma unroll 1
  for (int nt = blockIdx.x; nt < 8; nt += gridDim.x) {
    f32x4 acc[4][4];
    zero_acc(acc);
    gemm_kloop(yb + (size_t)TP * 1024, 1024, WbT + (size_t)nt * 128 * 1024, 1024, 1024, acc, smem);
    gemm_epilogue(acc, smem, TP, nt * 128, epiB);
  }
}

__device__ void phase_out(const P& p, char* smem) {
  const bf16_t* merged = (const bf16_t*)(p.ws + OFF_ACT);
  const bf16_t* WoutT = (const bf16_t*)(p.ws + OFF_WOUTT);
  const float* mod = (const float*)(p.ws + OFF_MOD);
  bf16_t* x1 = (bf16_t*)(p.ws + OFF_XBC);
  auto epi = [&](int row, int col, const float (&v)[8]) {
    const float* xr = (row < TP ? p.in[0] + (size_t)row * 1024 : p.in[1] + (size_t)(row - TP) * 1024) + col;
    const float* gt = mod + (size_t)mrow(row) * 6144 + 2048 + col;
    float4 a = *(const float4*)xr, b = *(const float4*)(xr + 4);
    float4 g0 = *(const float4*)gt, g1 = *(const float4*)(gt + 4);
    float o[8] = {a.x + g0.x * v[0], a.y + g0.y * v[1], a.z + g0.z * v[2], a.w + g0.w * v[3],
                  b.x + g1.x * v[4], b.y + g1.y * v[5], b.z + g1.z * v[6], b.w + g1.w * v[7]};
    store8bf(x1 + (size_t)row * 1024 + col, o);
  };
#pragma unroll 1
  for (int tile = blockIdx.x; tile < 512; tile += gridDim.x) {
    const int mt = tile >> 2, nt2 = tile & 3;
    f32x4 acc[4][8];
    zero_acc8(acc);
    gemm_kloop_n256(merged + (size_t)mt * 128 * 1024, 1024, WoutT + (size_t)nt2 * 256 * 1024, 1024, acc, smem);
    stage_all_bf16(acc, smem);
#pragma unroll 1
    for (int hh = 0; hh < 2; ++hh) epi_pass16(smem, hh, mt * 128, (nt2 * 2 + hh) * 128, epi);
    __syncthreads();
  }
#pragma unroll 1
  for (int nt = blockIdx.x; nt < 8; nt += gridDim.x) {
    f32x4 acc[4][4];
    zero_acc(acc);
    gemm_kloop(merged + (size_t)TP * 1024, 1024, WoutT + (size_t)nt * 128 * 1024, 1024, 1024, acc, smem);
    gemm_epilogue(acc, smem, TP, nt * 128, epi);
  }
}

__device__ void phase_query(const P& p, char* smem) {
  const bf16_t* h2 = (const bf16_t*)(p.ws + OFF_ACT);
  const bf16_t* WqT = (const bf16_t*)(p.ws + OFF_WQT);
  const bf16_t* keysB = (const bf16_t*)(p.ws + OFF_KEYS);
  float* topk1 = (float*)(p.ws + OFF_Z);
  const int tid = threadIdx.x, lane = tid & 63, wid = tid >> 6, wr = wid >> 1, wc = wid & 1, fr = lane & 15, fq = lane >> 4;
  for (int tile = blockIdx.x; tile < 129 * 16; tile += gridDim.x) {
    int mt = tile >> 4, nt = tile & 15;
    f32x4 acc[4][4];
    zero_acc(acc);
    gemm_kloop(h2 + (size_t)mt * 128 * 1024, 1024, WqT + (size_t)nt * 128 * 1024, 1024, 1024, acc, smem);
    bf16_t* Qs = (bf16_t*)smem;
    bf16_t* Ks = (bf16_t*)(smem + 34816);
#pragma unroll
    for (int m = 0; m < 4; ++m)
#pragma unroll
      for (int n = 0; n < 4; ++n)
#pragma unroll
        for (int r = 0; r < 4; ++r)
          Qs[(wr * 64 + m * 16 + fq * 4 + r) * 136 + wc * 64 + n * 16 + fr] = f2bf(acc[m][n][r]);
    {
      const bf16_t* kp = keysB + (size_t)nt * 16384;
#pragma unroll
      for (int i = 0; i < 8; ++i) {
        int idx = tid + 256 * i;
        int row = idx >> 4, c8 = (idx & 15) * 8;
        *(uint4*)(Ks + row * 136 + c8) = *(const uint4*)(kp + row * 128 + c8);
      }
    }
    __syncthreads();
    zero_acc(acc);
#pragma unroll
    for (int ks = 0; ks < 4; ++ks) {
      bf16x8 a[4], b[4];
#pragma unroll
      for (int m = 0; m < 4; ++m) a[m] = *(const bf16x8*)(Qs + (wr * 64 + m * 16 + fr) * 136 + ks * 32 + fq * 8);
#pragma unroll
      for (int n = 0; n < 4; ++n) b[n] = *(const bf16x8*)(Ks + (wc * 64 + n * 16 + fr) * 136 + ks * 32 + fq * 8);
#pragma unroll
      for (int m = 0; m < 4; ++m)
#pragma unroll
        for (int n = 0; n < 4; ++n)
          acc[m][n] = __builtin_amdgcn_mfma_f32_16x16x32_bf16(a[m], b[n], acc[m][n], 0, 0, 0);
    }
    __syncthreads();
    float* Sc = (float*)smem;
#pragma unroll
    for (int m = 0; m < 4; ++m)
#pragma unroll
      for (int n = 0; n < 4; ++n)
#pragma unroll
        for (int r = 0; r < 4; ++r) {
          int col = wc * 64 + n * 16 + fr;
          unsigned bits = (__float_as_uint(acc[m][n][r]) & ~127u) | (unsigned)(127 - col);
          Sc[(wr * 64 + m * 16 + fq * 4 + r) * 136 + col] = __uint_as_float(bits);
        }
    __syncthreads();
    {
      const int sub = lane & 15, grp = lane >> 4;
#pragma unroll 1
      for (int pass = 0; pass < 8; ++pass) {
        int row = wid * 32 + pass * 4 + grp;
        float v[8];
#pragma unroll
        for (int i = 0; i < 8; ++i) v[i] = Sc[row * 136 + sub + 16 * i];
#define CEX(i, j) { float hi_ = fmaxf(v[i], v[j]), lo_ = fminf(v[i], v[j]); v[i] = hi_; v[j] = lo_; }
        CEX(0, 1) CEX(2, 3) CEX(4, 5) CEX(6, 7)
        CEX(0, 2) CEX(1, 3) CEX(4, 6) CEX(5, 7)
        CEX(1, 2) CEX(5, 6)
        CEX(0, 4) CEX(1, 5) CEX(2, 6) CEX(3, 7)
        CEX(2, 4) CEX(3, 5)
        CEX(1, 2) CEX(3, 4) CEX(5, 6)
#undef CEX
        float mine = 0.f;
#pragma unroll
        for (int r = 0; r < 16; ++r) {
          const float m = row16_max(v[0]);
          const bool pop = (v[0] == m);
#pragma unroll
          for (int i = 0; i < 7; ++i) v[i] = pop ? v[i + 1] : v[i];
          v[7] = pop ? -INFINITY : v[7];
          if (sub == r) mine = m;
        }
        topk1[((size_t)(mt * 128 + row) * 16 + nt) * 16 + sub] = mine;
      }
    }
    __syncthreads();
  }
}

typedef __attribute__((ext_vector_type(2))) float f32x2_t;
DI void fp8x4_to_f32(unsigned w, float (&o)[4]) {
  f32x2_t lo = __builtin_amdgcn_cvt_pk_f32_fp8((int)w, false);
  f32x2_t hi = __builtin_amdgcn_cvt_pk_f32_fp8((int)w, true);
  o[0] = lo.x; o[1] = lo.y; o[2] = hi.x; o[3] = hi.y;
}
template <int NHD, bool COOP>
DI void peer_token(const P& p, char* smem, const int t, const int hd0, const int ci, const int cj) {
  const int lane = threadIdx.x & 63, wid = threadIdx.x >> 6;
  int* e_lds = (int*)(smem + wid * 4096);
  float* g_lds = (float*)(e_lds + 128);
  float* a_lds = g_lds + 128;
  float* sd_lds = a_lds + 128;
  float* su_lds = sd_lds + 128;
  const bf16_t* h2 = (const bf16_t*)(p.ws + OFF_ACT);
  const float* topk1 = (const float*)(p.ws + OFF_Z);
  const unsigned char* Ed = (const unsigned char*)(p.ws + OFF_E8);
  const unsigned char* Eu = Ed + 16777216;
  const float* Esc = (const float*)(p.ws + OFF_E8 + 33554432);
  const bf16_t* x1 = (const bf16_t*)(p.ws + OFF_XBC);
  const float* mod = (const float*)(p.ws + OFF_MOD);
  const float* modf = (const float*)(p.ws + OFF_MODF);
  const float* gfin = p.in[36];
  const int sub = lane & 15, grp = lane >> 4;
    f32x2_t hq2[32];
#pragma unroll
    for (int i = 0; i < 4; ++i) {
      const bf16_t* hp = h2 + (size_t)t * 1024 + i * 256 + sub * 16;
      uint4 u0 = *(const uint4*)hp, u1 = *(const uint4*)(hp + 8);
      float f0[8], f1[8];
      unpack8(u0, f0); unpack8(u1, f1);
#pragma unroll
      for (int j = 0; j < 4; ++j) {
        hq2[i * 8 + j] = f32x2_t{f0[2 * j], f0[2 * j + 1]};
        hq2[i * 8 + 4 + j] = f32x2_t{f1[2 * j], f1[2 * j + 1]};
      }
    }
    float tkv0[NHD], tkv1[NHD];
#pragma unroll
    for (int q = 0; q < NHD; ++q) {
      const float* tk = topk1 + ((size_t)t * 16 + (hd0 + q) * 2) * 16;
      tkv0[q] = tk[ci >= 0 ? ci : 0]; tkv1[q] = tk[16 + cj];
    }
#pragma unroll
    for (int hq_ = 0; hq_ < NHD; ++hq_) {
      const int hd = hd0 + hq_;
      float v0 = tkv0[hq_], v1 = tkv1[hq_];
      unsigned b0 = __float_as_uint(v0), b1 = __float_as_uint(v1);
      int i0 = 127 - (int)(b0 & 127u), i1 = 127 - (int)(b1 & 127u);
      float cand = __uint_as_float(b0 & ~127u) + __uint_as_float(b1 & ~127u);
      int eidx = i0 * 128 + i1;
      float key = (ci >= 0) ? __uint_as_float((__float_as_uint(cand) & ~63u) | (unsigned)(63 - lane)) : -INFINITY;
      int rank = 0;
#pragma unroll
      for (int j = 0; j < 50; ++j) {
        float kj = __builtin_bit_cast(float, __builtin_amdgcn_readlane(__builtin_bit_cast(int, key), j));
        rank += (kj > key) ? 1 : 0;
      }
      const bool sel = (ci >= 0) && (rank < 16);
      float fv = __uint_as_float(__float_as_uint(key) & ~63u);
      float mx = __builtin_bit_cast(float, __builtin_amdgcn_readlane(__builtin_bit_cast(int, fv), 0));
      float ex = sel ? __expf(fv - mx) : 0.f;
      float sm = wave_sum_fast(ex);
      if (sel) {
        e_lds[(hd - hd0) * 16 + rank] = eidx; g_lds[(hd - hd0) * 16 + rank] = ex / sm;
        sd_lds[(hd - hd0) * 16 + rank] = Esc[eidx]; su_lds[(hd - hd0) * 16 + rank] = Esc[16384 + eidx];
      }
    }
    __builtin_amdgcn_fence(__ATOMIC_RELEASE, "workgroup");
    __builtin_amdgcn_wave_barrier();
#pragma unroll 2
    for (int it = 0; it < NHD * 4; ++it) {
      int slot = it * 4 + grp;
      int e = e_lds[slot];
      const uint4* row = (const uint4*)(Ed + (size_t)e * 1024 + sub * 16);
      uint4 wv[4];
#pragma unroll
      for (int i = 0; i < 4; ++i) wv[i] = row[i * 16];
      f32x2_t acc2 = {0.f, 0.f}, acc3 = {0.f, 0.f};
#pragma unroll
      for (int i = 0; i < 4; ++i) {
        const unsigned ww[4] = {wv[i].x, wv[i].y, wv[i].z, wv[i].w};
#pragma unroll
        for (int j = 0; j < 4; ++j) {
          const f32x2_t lo = __builtin_amdgcn_cvt_pk_f32_fp8((int)ww[j], false);
          const f32x2_t hi = __builtin_amdgcn_cvt_pk_f32_fp8((int)ww[j], true);
          acc2 = lo * hq2[i * 8 + j * 2] + acc2;
          acc3 = hi * hq2[i * 8 + j * 2 + 1] + acc3;
        }
      }
      float acc = (acc2.x + acc2.y) + (acc3.x + acc3.y);
      acc = row16_sum(acc);
      float act = geluf(acc * sd_lds[slot]) * g_lds[slot] * su_lds[slot];
      if (sub == 0) a_lds[slot] = act;
    }
    __builtin_amdgcn_fence(__ATOMIC_RELEASE, "workgroup");
    __builtin_amdgcn_wave_barrier();
    f32x2_t o2[8];
#pragma unroll
    for (int i = 0; i < 8; ++i) o2[i] = f32x2_t{0.f, 0.f};
#pragma unroll 8
    for (int s = 0; s < NHD * 16; ++s) {
      int e = e_lds[s];
      const float a = a_lds[s];
      const f32x2_t a2 = {a, a};
      uint4 w = *(const uint4*)(Eu + (size_t)e * 1024 + lane * 16);
      const unsigned ww[4] = {w.x, w.y, w.z, w.w};
#pragma unroll
      for (int j = 0; j < 4; ++j) {
        o2[2 * j] = __builtin_amdgcn_cvt_pk_f32_fp8((int)ww[j], false) * a2 + o2[2 * j];
        o2[2 * j + 1] = __builtin_amdgcn_cvt_pk_f32_fp8((int)ww[j], true) * a2 + o2[2 * j + 1];
      }
    }
    float o[16];
#pragma unroll
    for (int i = 0; i < 8; ++i) { o[2 * i] = o2[i].x; o[2 * i + 1] = o2[i].y; }
    if (COOP) {
      float* part = (float*)(smem + 16384);
#pragma unroll
      for (int i = 0; i < 16; ++i) part[wid * 1024 + lane * 16 + i] = o[i];
      __syncthreads();
      if (wid != 0) return;
#pragma unroll
      for (int i = 0; i < 16; ++i) o[i] = part[lane * 16 + i] + part[1024 + lane * 16 + i] + part[2048 + lane * 16 + i] + part[3072 + lane * 16 + i];
    }
    const int mr = mrow(t);
    const int c0 = lane * 16;
    float x2[16];
    float ss = 0.f;
    {
      const bf16_t* xr = x1 + (size_t)t * 1024 + c0;
      const float* gt = mod + (size_t)mr * 6144 + 5120 + c0;
      uint4 xa = *(const uint4*)xr, xb2 = *(const uint4*)(xr + 8);
      float xf[16];
      {
        float f0[8], f1[8];
        unpack8(xa, f0); unpack8(xb2, f1);
#pragma unroll
        for (int i = 0; i < 8; ++i) { xf[i] = f0[i]; xf[8 + i] = f1[i]; }
      }
#pragma unroll
      for (int q = 0; q < 4; ++q) {
        float4 g = *(const float4*)(gt + 4 * q);
        x2[4 * q + 0] = xf[4 * q + 0] + g.x * o[4 * q + 0]; x2[4 * q + 1] = xf[4 * q + 1] + g.y * o[4 * q + 1];
        x2[4 * q + 2] = xf[4 * q + 2] + g.z * o[4 * q + 2]; x2[4 * q + 3] = xf[4 * q + 3] + g.w * o[4 * q + 3];
      }
    }
#pragma unroll
    for (int i = 0; i < 16; ++i) ss += x2[i] * x2[i];
    ss = wave_sum_fast(ss);
    float rs = rsqrtf(ss * (1.f / 1024.f) + 1e-6f);
    {
      const float* sh = modf + (size_t)mr * 2048 + c0;
      const float* sc = sh + 1024;
      float* d = p.out + O_Y + (size_t)t * 1024 + c0;
#pragma unroll
      for (int q = 0; q < 4; ++q) {
        float4 shv = *(const float4*)(sh + 4 * q), scv = *(const float4*)(sc + 4 * q), gf = *(const float4*)(gfin + c0 + 4 * q);
        float4 y;
        y.x = x2[4 * q + 0] * rs * gf.x * (1.f + scv.x) + shv.x;
        y.y = x2[4 * q + 1] * rs * gf.y * (1.f + scv.y) + shv.y;
        y.z = x2[4 * q + 2] * rs * gf.z * (1.f + scv.z) + shv.z;
        y.w = x2[4 * q + 3] * rs * gf.w * (1.f + scv.w) + shv.w;
        *(float4*)(d + 4 * q) = y;
      }
    }
    __builtin_amdgcn_fence(__ATOMIC_RELEASE, "workgroup");
    __builtin_amdgcn_wave_barrier();
}

__device__ void phase_peer(const P& p, char* smem) {
  const int lane = threadIdx.x & 63, wid = threadIdx.x >> 6;
  int ci = -1, cj = 0;
  {
    int c = lane;
#pragma unroll
    for (int i = 0; i < 16; ++i) {
      int cnt = 16 / (i + 1);
      if (ci < 0) { if (c < cnt) { ci = i; cj = c; } else c -= cnt; }
    }
  }
#pragma unroll 1
  for (int t = blockIdx.x * 4 + wid; t < TP; t += gridDim.x * 4) peer_token<8, false>(p, smem, t, 0, ci, cj);
#pragma unroll 1
  for (int b = blockIdx.x; b < TT - TP; b += gridDim.x) {
    __syncthreads();
    peer_token<2, true>(p, smem, TP + b, wid * 2, ci, cj);
    __syncthreads();
  }
}

template <int PH>
DI void run_phase(const P& p, char* smem) {
  if constexpr (PH == 0) phase0(p, smem);
  else if constexpr (PH == 1) phase_mod(p, smem);
  else if constexpr (PH == 2) phase_norm(p, 0);
  else if constexpr (PH == 3) phase_inproj(p, smem);
  else if constexpr (PH == 4) phase_mixers(p, smem);
  else if constexpr (PH == 5) phase_glu(p, smem);
  else if constexpr (PH == 6) phase_merge(p, smem);
  else if constexpr (PH == 7) phase_out(p, smem);
  else if constexpr (PH == 8) phase_norm(p, 1);
  else if constexpr (PH == 9) phase_query(p, smem);
  else phase_peer(p, smem);
}

#define XB_TMO      128
#define XB_XCNT(j)  (256  + 64 * (j))
#define XB_XSUB(j)  (1280 + 64 * (j))
#define XB_XGEN(j)  (2304 + 64 * (j))
#define XB_TOP      3328
#define XB_TOPGEN   3392
#define XCD_BAR_WORDS 3456
#define XB_SPIN_CAP (1u << 20)
#define LAS __attribute__((address_space(3)))

__device__ __forceinline__ unsigned xb_ld(unsigned* p)              { return __hip_atomic_load(p, __ATOMIC_RELAXED, __HIP_MEMORY_SCOPE_AGENT); }
__device__ __forceinline__ unsigned xb_add(unsigned* p, unsigned v) { return __hip_atomic_fetch_add(p, v, __ATOMIC_RELAXED, __HIP_MEMORY_SCOPE_AGENT); }
__device__ __forceinline__ unsigned xb_xcc_id() { return (unsigned)__builtin_amdgcn_s_getreg((3 << 11) | 20) & 0xFu; }
#define XB_SPIN(cond, bar) do { unsigned _sp = 0; while (cond) { __builtin_amdgcn_s_sleep(1); \
    if ((++_sp & 255u) == 0u) { if (xb_ld(&(bar)[XB_TMO])) break; if (_sp > XB_SPIN_CAP) { atomicAdd(&(bar)[XB_TMO], 1u); break; } } } } while (0)

struct XcdBarrier {
    unsigned* bar; unsigned x;
    volatile LAS unsigned* st;
};

__device__ __forceinline__ XcdBarrier xcd_barrier_post(unsigned* bar, volatile LAS unsigned* st) {
    XcdBarrier b; b.bar = bar; b.x = xb_xcc_id(); b.st = st;
    if (threadIdx.x == 0) (void)xb_add(&bar[XB_XCNT(b.x)], 1u);
    return b;
}
__device__ __forceinline__ void xcd_barrier_complete(unsigned* bar, unsigned x, unsigned& nloc, unsigned& nx) {
    const unsigned G = gridDim.x * gridDim.y * gridDim.z;
    unsigned sum, cnt, mine, sp = 0u;
    for (;;) {
        sum = 0u; cnt = 0u; mine = 0u;
#pragma unroll
        for (unsigned j = 0; j < 16; ++j) { const unsigned c = xb_ld(&bar[XB_XCNT(j)]); sum += c; cnt += (c > 0u) ? 1u : 0u; mine = (j == x) ? c : mine; }
        if (sum == G) break;
        __builtin_amdgcn_s_sleep(1);
        if ((++sp & 255u) == 0u) { if (xb_ld(&bar[XB_TMO])) break; if (sp > XB_SPIN_CAP) { atomicAdd(&bar[XB_TMO], 1u); break; } }
    }
    nloc = mine > 0u ? mine : 1u; nx = cnt > 0u ? cnt : 1u;
}

__device__ __forceinline__ void xcd_barrier(const XcdBarrier& b) {
    asm volatile("s_waitcnt vmcnt(0)" ::: "memory");
    __syncthreads();
    if (threadIdx.x == 0) {
        unsigned* bar = b.bar;
        __builtin_amdgcn_s_waitcnt(0);
        unsigned nloc = b.st[0], nx = b.st[1];
        if (nloc == 0u) { xcd_barrier_complete(bar, b.x, nloc, nx); b.st[0] = nloc; b.st[1] = nx; }
        const unsigned old = xb_add(&bar[XB_XSUB(b.x)], 1u);
        const unsigned gen = old / nloc;
        if (old + 1u == (gen + 1u) * nloc) {
            __builtin_amdgcn_fence(__ATOMIC_RELEASE, "agent");
            asm volatile("s_waitcnt vmcnt(0)" ::: "memory");
            const unsigned og = xb_add(&bar[XB_TOP], 1u);
            const unsigned tg = og / nx;
            if (og + 1u == (tg + 1u) * nx) xb_add(&bar[XB_TOPGEN], 1u);
            else XB_SPIN(xb_ld(&bar[XB_TOPGEN]) == tg, bar);
            __builtin_amdgcn_fence(__ATOMIC_ACQUIRE, "agent");
            xb_add(&bar[XB_XGEN(b.x)], 1u);
            asm volatile("s_waitcnt vmcnt(0)" ::: "memory");
        } else {
            XB_SPIN(xb_ld(&bar[XB_XGEN(b.x)]) == gen, bar);
            __builtin_amdgcn_fence(__ATOMIC_ACQUIRE, "agent");
            asm volatile("s_waitcnt vmcnt(0)" ::: "memory");
        }
    }
    __syncthreads();
}


__global__ void __launch_bounds__(256, 2) mega(P p) {
  extern __shared__ __attribute__((aligned(16))) char smem[];
  cg::grid_group grid = cg::this_grid();
  if (threadIdx.x == 0) *(uint4*)(smem + 80384) = make_uint4(0u, 0u, 0u, 0u);
  __syncthreads();
  XcdBarrier xb = xcd_barrier_post((unsigned*)(p.ws + OFF_BAR), (volatile LAS unsigned*)(smem + 80384));
  if (p.ws == nullptr) grid.sync();
  run_phase<0>(p, smem);  xcd_barrier(xb);
  run_phase<1>(p, smem);  xcd_barrier(xb);
  run_phase<2>(p, smem);  xcd_barrier(xb);
  run_phase<3>(p, smem);  xcd_barrier(xb);
  phase_convfix(p);       xcd_barrier(xb);
  run_phase<4>(p, smem);  xcd_barrier(xb);
  run_phase<5>(p, smem);  xcd_barrier(xb);
  run_phase<6>(p, smem);  xcd_barrier(xb);
  run_phase<7>(p, smem);  xcd_barrier(xb);
  run_phase<8>(p, smem);  xcd_barrier(xb);
  run_phase<9>(p, smem);  xcd_barrier(xb);
  run_phase<10>(p, smem);
}

extern "C" void kernel_launch(void* const* d_in, const int* in_sizes, int n_in, void* d_out, int out_size,
                              void* d_ws, size_t ws_size, hipStream_t stream) {
  static int grid_blocks = 0;
  if (!grid_blocks) {
    int dev = 0, cus = 0, per_cu = 0;
    (void)hipGetDevice(&dev);
    (void)hipDeviceGetAttribute(&cus, hipDeviceAttributeMultiprocessorCount, dev);
    (void)hipFuncSetAttribute((const void*)mega, hipFuncAttributeMaxDynamicSharedMemorySize, SMEM_BYTES);
    (void)hipOccupancyMaxActiveBlocksPerMultiprocessor(&per_cu, mega, 256, SMEM_BYTES);
    if (per_cu < 1) per_cu = 1;
    if (per_cu > 2) per_cu = 2;
    grid_blocks = cus * per_cu;
  }
  if (ws_size < WS_NEED) { fprintf(stderr, "workspace too small: %zu < %zu\n", ws_size, (size_t)WS_NEED); return; }
  P p{};
  for (int i = 0; i < 39; ++i) p.in[i] = (const float*)d_in[i];
  p.out = (float*)d_out;
  p.ws = (char*)d_ws;
  (void)hipMemsetAsync((char*)d_ws + OFF_BAR, 0, 16384, stream);
  void* args[] = {&p};
  hipError_t e = hipLaunchCooperativeKernel((void*)mega, dim3(grid_blocks), dim3(256), args, SMEM_BYTES, stream);
  if (e != hipSuccess) fprintf(stderr, "cooperative launch failed: %s (grid %d)\n", hipGetErrorString(e), grid_blocks);
}
```

```cpp
#include <hip/hip_runtime.h>
#include <hip/hip_cooperative_groups.h>
#include <cstdio>
#include <cstdint>
namespace cg = cooperative_groups;

typedef unsigned short bf16_t;
using bf16x8 = __attribute__((ext_vector_type(8))) short;
using bf16x2v = __attribute__((ext_vector_type(2))) __bf16;
using f32x4 = __attribute__((ext_vector_type(4))) float;
using f32x16 = __attribute__((ext_vector_type(16))) float;
#define DI __device__ __forceinline__

struct P { const float* in[39]; float* out; char* ws; };

constexpr int TT = 16512, TP = 16384;
constexpr size_t OFF_WINT = 0;
constexpr size_t OFF_WGLUT = OFF_WINT + 12058624;
constexpr size_t OFF_WAT = OFF_WGLUT + 524288;
constexpr size_t OFF_WBT = OFF_WAT + 1048576;
constexpr size_t OFF_WOUTT = OFF_WBT + 2097152;
constexpr size_t OFF_WQT = OFF_WOUTT + 2097152;
constexpr size_t OFF_KEYS = OFF_WQT + 4194304;
constexpr size_t OFF_SCB = OFF_KEYS + 524288;
constexpr size_t OFF_MOD = OFF_SCB + 524288;
constexpr size_t OFF_MODF = OFF_MOD + 3342336;
constexpr size_t OFF_DTB = OFF_MODF + 1114112;
constexpr size_t OFF_ACT = OFF_DTB + 1056768;
constexpr size_t OFF_U = OFF_ACT + 33816576;
constexpr size_t OFF_Z = OFF_U + 16908288;
constexpr size_t OFF_XBC = OFF_Z + 33816576;
constexpr size_t OFF_GATES = OFF_XBC + 67633152;
constexpr size_t OFF_YS5 = OFF_GATES + 67633152;
constexpr size_t OFF_YSSD = OFF_YS5 + 16908288;
constexpr size_t OFF_BAR = OFF_YSSD + 33816576;
constexpr size_t OFF_TAILS = OFF_BAR + 16384;
constexpr size_t OFF_E8 = OFF_TAILS + 1572864;
constexpr size_t WS_NEED = OFF_E8 + 33554432 + 131072;

constexpr size_t O_Y = 0;
constexpr size_t O_S5RE_P = 16908288;
constexpr size_t O_S5IM_P = O_S5RE_P + 16384;
constexpr size_t O_SSM_P = O_S5IM_P + 16384;
constexpr size_t O_CONV_P = O_SSM_P + 1048576;
constexpr size_t O_S5RE_S = O_CONV_P + 49152;
constexpr size_t O_S5IM_S = O_S5RE_S + 262144;
constexpr size_t O_SSM_S = O_S5IM_S + 262144;
constexpr size_t O_CONV_S = O_SSM_S + 16777216;

constexpr int SMEM_BYTES = 80400;

DI float bf2f(bf16_t b) { return __uint_as_float(((unsigned)b) << 16); }
DI float bflo(unsigned u) { return __uint_as_float(u << 16); }
DI float bfhi(unsigned u) { return __uint_as_float(u & 0xffff0000u); }
typedef __attribute__((ext_vector_type(2))) float f2v_t;
typedef __attribute__((ext_vector_type(2))) __bf16 b2v_t;
DI unsigned cvtpk(float lo, float hi) { f2v_t v = {lo, hi}; b2v_t r = __builtin_convertvector(v, b2v_t); return __builtin_bit_cast(unsigned, r); }
typedef __attribute__((ext_vector_type(4))) unsigned u32x4_t;
DI bf16x8 mk8(unsigned a, unsigned b, unsigned c, unsigned d) { u32x4_t v = {a, b, c, d}; return __builtin_bit_cast(bf16x8, v); }
DI bf16_t f2bf(float f) { return (bf16_t)(cvtpk(f, 0.f) & 0xffffu); }
DI float siluf(float x) { return x * __builtin_amdgcn_rcpf(1.f + __expf(-x)); }
DI float sigmf(float x) { return __builtin_amdgcn_rcpf(1.f + __expf(-x)); }
DI float erf_as(float x) {
  const float ax = fabsf(x);
  const float t = __builtin_amdgcn_rcpf(1.f + 0.3275911f * ax);
  const float poly = t * (0.254829592f + t * (-0.284496736f + t * (1.421413741f + t * (-1.453152027f + t * 1.061405429f))));
  const float r = 1.f - poly * __expf(-ax * ax);
  return copysignf(r, x);
}
DI float geluf(float x) { return 0.5f * x * (1.f + erf_as(x * 0.70710678118654752f)); }
DI float dot2(unsigned a, unsigned b, float acc) {
  return __builtin_amdgcn_fdot2_f32_bf16(__builtin_bit_cast(bf16x2v, a), __builtin_bit_cast(bf16x2v, b), acc, false);
}
DI float wave_sum(float v) {
#pragma unroll
  for (int o = 32; o; o >>= 1) v += __shfl_xor(v, o);
  return v;
}
DI float wave_max(float v) {
#pragma unroll
  for (int o = 32; o; o >>= 1) v = fmaxf(v, __shfl_xor(v, o));
  return v;
}
template <int CTRL> DI float dppf(float x) {
  return __builtin_bit_cast(float, __builtin_amdgcn_mov_dpp(__builtin_bit_cast(int, x), CTRL, 0xf, 0xf, true));
}
DI float row16_max(float m) {
  m = fmaxf(m, dppf<0xB1>(m)); m = fmaxf(m, dppf<0x4E>(m)); m = fmaxf(m, dppf<0x141>(m)); m = fmaxf(m, dppf<0x128>(m));
  return m;
}
DI float row16_sum(float s) {
  s += dppf<0xB1>(s); s += dppf<0x4E>(s); s += dppf<0x141>(s); s += dppf<0x128>(s);
  return s;
}
DI float xrow16_sum(float x) {
  auto a = __builtin_amdgcn_permlane16_swap(__float_as_uint(x), __float_as_uint(x), false, false);
  x = __uint_as_float(a[0]) + __uint_as_float(a[1]);
  auto b = __builtin_amdgcn_permlane32_swap(__float_as_uint(x), __float_as_uint(x), false, false);
  return __uint_as_float(b[0]) + __uint_as_float(b[1]);
}
DI float wave_sum_fast(float s) { return xrow16_sum(row16_sum(s)); }
DI float wave_incl_scan(float v) {
  v += __builtin_bit_cast(float, __builtin_amdgcn_update_dpp(0, __builtin_bit_cast(int, v), 0x111, 0xf, 0xf, true));
  v += __builtin_bit_cast(float, __builtin_amdgcn_update_dpp(0, __builtin_bit_cast(int, v), 0x112, 0xf, 0xf, true));
  v += __builtin_bit_cast(float, __builtin_amdgcn_update_dpp(0, __builtin_bit_cast(int, v), 0x114, 0xf, 0xf, true));
  v += __builtin_bit_cast(float, __builtin_amdgcn_update_dpp(0, __builtin_bit_cast(int, v), 0x118, 0xf, 0xf, true));
  v += __builtin_bit_cast(float, __builtin_amdgcn_update_dpp(0, __builtin_bit_cast(int, v), 0x142, 0xa, 0xf, false));
  v += __builtin_bit_cast(float, __builtin_amdgcn_update_dpp(0, __builtin_bit_cast(int, v), 0x143, 0xc, 0xf, false));
  return v;
}
DI int mrow(int t) { return t < TP ? (t >> 11) : (8 + t - TP); }
DI void store8bf(bf16_t* dst, const float (&v)[8]) {
  uint4 o; o.x = cvtpk(v[0], v[1]); o.y = cvtpk(v[2], v[3]); o.z = cvtpk(v[4], v[5]); o.w = cvtpk(v[6], v[7]);
  *(uint4*)dst = o;
}
DI void unpack8(const uint4& u, float (&v)[8]) {
  v[0] = bflo(u.x); v[1] = bfhi(u.x); v[2] = bflo(u.y); v[3] = bfhi(u.y);
  v[4] = bflo(u.z); v[5] = bfhi(u.z); v[6] = bflo(u.w); v[7] = bfhi(u.w);
}

DI void tconv_tile(const float* __restrict__ src, int ldsrc, int srccol0, int nvalid, int k0,
                   bf16_t* __restrict__ dst, int lddst, int dstrow0, char* smem) {
  float* tile = (float*)smem;
  const int tid = threadIdx.x;
  const int nn = tid & 63, kb = tid >> 6;
#pragma unroll
  for (int i = 0; i < 16; ++i) {
    int kk = kb + 4 * i;
    float v = (nn < nvalid) ? src[(size_t)(k0 + kk) * ldsrc + srccol0 + nn] : 0.f;
    tile[kk * 65 + nn] = v;
  }
  __syncthreads();
  const int n = tid >> 2, kq = (tid & 3) * 16;
  unsigned o[8];
#pragma unroll
  for (int i = 0; i < 8; ++i) o[i] = cvtpk(tile[(kq + 2 * i) * 65 + n], tile[(kq + 2 * i + 1) * 65 + n]);
  const int nrow = dstrow0 + n, kk = k0 + kq;
  uint4* d = (uint4*)(dst + ((size_t)((nrow >> 7) * (lddst >> 5) + (kk >> 5)) * 128 + (nrow & 127)) * 32 + (kk & 31));
  d[0] = make_uint4(o[0], o[1], o[2], o[3]);
  d[1] = make_uint4(o[4], o[5], o[6], o[7]);
  __syncthreads();
}

constexpr int LDT = 72;
constexpr int TILE_ELEMS = 128 * LDT;

#define GLDS16(g, l) __builtin_amdgcn_global_load_lds((const unsigned*)(g), (unsigned*)(l), 16, 0, 0)
DI void gemm_kloop(const bf16_t* __restrict__ A, int lda, const bf16_t* __restrict__ B, int ldb, int K,
                   f32x4 (&acc)[4][4], char* smem) {
  const int tid = threadIdx.x, lane = tid & 63, wid = tid >> 6, wr = wid >> 1, wc = wid & 1, fr = lane & 15, fq = lane >> 4;
  const int r0 = tid >> 2;
  const int fsw = (0x78 >> (2 * ((r0 >> 2) & 3))) & 3;
  const int csrc = ((tid & 3) ^ fsw) * 8;
  const bf16_t* Ap0 = A + (size_t)r0 * lda + csrc;
  const bf16_t* Ap1 = A + (size_t)(r0 + 64) * lda + csrc;
  const bf16_t* Bp0 = B + r0 * 32 + csrc;
  const bf16_t* Bp1 = Bp0 + 2048;
  char* lw = smem + tid * 16;
  const int posl = (fq ^ ((0x78 >> (2 * ((fr >> 2) & 3))) & 3)) * 16;
  const char* ardA = smem + (wr * 64 + fr) * 64 + posl;
  const char* ardB = smem + 8192 + (wc * 64 + fr) * 64 + posl;
  const int nk = K >> 5;
  auto issue = [&](int kt) __attribute__((always_inline)) {
    char* base = lw + (kt & 3) * 16384;
    GLDS16(Ap0 + kt * 32, base);
    GLDS16(Ap1 + kt * 32, base + 4096);
    GLDS16(Bp0 + kt * 4096, base + 8192);
    GLDS16(Bp1 + kt * 4096, base + 12288);
  };
  issue(0); issue(1); issue(2);
#pragma unroll 1
  for (int kt = 0; kt < nk; ++kt) {
    if (kt + 2 < nk) asm volatile("s_waitcnt vmcnt(8)" ::: "memory");
    else if (kt + 1 < nk) asm volatile("s_waitcnt vmcnt(4)" ::: "memory");
    else asm volatile("s_waitcnt vmcnt(0)" ::: "memory");
    __builtin_amdgcn_s_barrier();
    if (kt + 3 < nk) issue(kt + 3);
    const char* pa = ardA + (kt & 3) * 16384;
    const char* pb = ardB + (kt & 3) * 16384;
    bf16x8 a[4], b[4];
#pragma unroll
    for (int m = 0; m < 4; ++m) a[m] = *(const bf16x8*)(pa + m * 1024);
#pragma unroll
    for (int n = 0; n < 4; ++n) b[n] = *(const bf16x8*)(pb + n * 1024);
#pragma unroll
    for (int m = 0; m < 4; ++m)
#pragma unroll
      for (int n = 0; n < 4; ++n)
        acc[m][n] = __builtin_amdgcn_mfma_f32_16x16x32_bf16(a[m], b[n], acc[m][n], 0, 0, 0);
  }
  __syncthreads();
}

DI void gemm_kloop_n256(const bf16_t* __restrict__ A, int lda, const bf16_t* __restrict__ B, int K,
                        f32x4 (&acc)[4][8], char* smem) {
  const int tid = threadIdx.x, lane = tid & 63, wid = tid >> 6, wr = wid >> 1, wc = wid & 1, fr = lane & 15, fq = lane >> 4;
  const int r0 = tid >> 2;
  const int fsw = (0x78 >> (2 * ((r0 >> 2) & 3))) & 3;
  const int csrc = ((tid & 3) ^ fsw) * 8;
  const bf16_t* Ap0 = A + (size_t)r0 * lda + csrc;
  const bf16_t* Ap1 = A + (size_t)(r0 + 64) * lda + csrc;
  const bf16_t* Bp0 = B + r0 * 32 + csrc;
  const bf16_t* Bp2 = Bp0 + (size_t)128 * K;
  char* lw = smem + tid * 16;
  const int posl = (fq ^ ((0x78 >> (2 * ((fr >> 2) & 3))) & 3)) * 16;
  const char* ardA = smem + (wr * 64 + fr) * 64 + posl;
  const char* ardB = smem + 8192 + (wc * 128 + fr) * 64 + posl;
  const int nk = K >> 5;
  auto issue = [&](int kt, int stg) __attribute__((always_inline)) {
    char* base = lw + stg * 24576;
    GLDS16(Ap0 + kt * 32, base);
    GLDS16(Ap1 + kt * 32, base + 4096);
    GLDS16(Bp0 + kt * 4096, base + 8192);
    GLDS16(Bp0 + kt * 4096 + 2048, base + 12288);
    GLDS16(Bp2 + kt * 4096, base + 16384);
    GLDS16(Bp2 + kt * 4096 + 2048, base + 20480);
  };
  issue(0, 0); issue(1, 1);
  int stg = 0;
#pragma unroll 1
  for (int kt = 0; kt < nk; ++kt) {
    if (kt + 1 < nk) asm volatile("s_waitcnt vmcnt(6)" ::: "memory");
    else asm volatile("s_waitcnt vmcnt(0)" ::: "memory");
    __builtin_amdgcn_s_barrier();
    const int stg2 = (stg == 0) ? 2 : stg - 1;
    if (kt + 2 < nk) issue(kt + 2, stg2);
    const char* pa = ardA + stg * 24576;
    const char* pb = ardB + stg * 24576;
    bf16x8 a[4], b[8];
#pragma unroll
    for (int m = 0; m < 4; ++m) a[m] = *(const bf16x8*)(pa + m * 1024);
#pragma unroll
    for (int n = 0; n < 8; ++n) b[n] = *(const bf16x8*)(pb + n * 1024);
    __builtin_amdgcn_s_setprio(1);
#pragma unroll
    for (int m = 0; m < 4; ++m)
#pragma unroll
      for (int n = 0; n < 8; ++n)
        acc[m][n] = __builtin_amdgcn_mfma_f32_16x16x32_bf16(a[m], b[n], acc[m][n], 0, 0, 0);
    __builtin_amdgcn_s_setprio(0);
    stg = (stg == 2) ? 0 : stg + 1;
  }
  __syncthreads();
}
DI void zero_acc8(f32x4 (&acc)[4][8]) {
#pragma unroll
  for (int m = 0; m < 4; ++m)
#pragma unroll
    for (int n = 0; n < 8; ++n) acc[m][n] = f32x4{0.f, 0.f, 0.f, 0.f};
}
constexpr int CS16 = 264;
DI void stage_all_bf16(f32x4 (&acc)[4][8], char* smem) {
  const int tid = threadIdx.x, lane = tid & 63, wid = tid >> 6, wr = wid >> 1, wc = wid & 1, fr = lane & 15, fq = lane >> 4;
  bf16_t* Cs = (bf16_t*)smem;
#pragma unroll
  for (int m = 0; m < 4; ++m)
#pragma unroll
    for (int n = 0; n < 8; ++n)
#pragma unroll
      for (int r = 0; r < 4; ++r)
        Cs[(wr * 64 + m * 16 + fq * 4 + r) * CS16 + wc * 128 + n * 16 + fr] = f2bf(acc[m][n][r]);
  __syncthreads();
}
DI void cs16_load8(const bf16_t* Cs, int row, int col, float (&v)[8]) {
  uint4 u = *(const uint4*)(Cs + row * CS16 + col);
  unpack8(u, v);
}
template <class Epi>
DI void epi_pass16(char* smem, int hh, int row0, int col0, Epi epi) {
  const int tid = threadIdx.x;
  const bf16_t* Cs = (const bf16_t*)smem;
#pragma unroll
  for (int i = 0; i < 8; ++i) {
    int idx = tid + 256 * i;
    int row = idx >> 4, c8 = (idx & 15) * 8;
    float v[8];
    cs16_load8(Cs, row, hh * 128 + c8, v);
    epi(row0 + row, col0 + c8, v);
  }
}
DI void zero_acc(f32x4 (&acc)[4][4]) {
#pragma unroll
  for (int m = 0; m < 4; ++m)
#pragma unroll
    for (int n = 0; n < 4; ++n) acc[m][n] = f32x4{0.f, 0.f, 0.f, 0.f};
}

template <class Epi>
DI void gemm_epilogue(f32x4 (&acc)[4][4], char* smem, int row0, int col0, Epi epi) {
  const int tid = threadIdx.x, lane = tid & 63, wid = tid >> 6, wr = wid >> 1, wc = wid & 1, fr = lane & 15, fq = lane >> 4;
  float* Cs = (float*)smem;
#pragma unroll
  for (int m = 0; m < 4; ++m)
#pragma unroll
    for (int n = 0; n < 4; ++n)
#pragma unroll
      for (int r = 0; r < 4; ++r)
        Cs[(wr * 64 + m * 16 + fq * 4 + r) * 132 + wc * 64 + n * 16 + fr] = acc[m][n][r];
  __syncthreads();
#pragma unroll
  for (int i = 0; i < 8; ++i) {
    int idx = tid + 256 * i;
    int row = idx >> 4, c8 = (idx & 15) * 8;
    float4 x0 = *(const float4*)(Cs + row * 132 + c8);
    float4 x1 = *(const float4*)(Cs + row * 132 + c8 + 4);
    float v[8] = {x0.x, x0.y, x0.z, x0.w, x1.x, x1.y, x1.z, x1.w};
    epi(row0 + row, col0 + c8, v);
  }
  __syncthreads();
}

__device__ void phase0(const P& p, char* smem) {
  bf16_t* WinT = (bf16_t*)(p.ws + OFF_WINT);
  bf16_t* WadaT = (bf16_t*)(p.ws + OFF_YS5);
  bf16_t* WgluT = (bf16_t*)(p.ws + OFF_WGLUT);
  bf16_t* WaT = (bf16_t*)(p.ws + OFF_WAT);
  bf16_t* WbT = (bf16_t*)(p.ws + OFF_WBT);
  bf16_t* WoutT = (bf16_t*)(p.ws + OFF_WOUTT);
  bf16_t* WqT = (bf16_t*)(p.ws + OFF_WQT);
  bf16_t* keysB = (bf16_t*)(p.ws + OFF_KEYS);
  bf16_t* scb = (bf16_t*)(p.ws + OFF_SCB);
  const int tid = threadIdx.x;
  const int NTASK = 2048 + 128 + 128 + 256;
  for (int task = blockIdx.x; task < NTASK; task += gridDim.x) {
    int t = task;
    if (t < 1536) { int nt = t >> 4, kt = t & 15; tconv_tile(p.in[8], 6144, nt * 64, 64, kt * 64, WadaT, 1024, nt * 64, smem); continue; }
    t -= 1536;
    if (t < 512) { int nt = t >> 4, kt = t & 15; tconv_tile(p.in[37], 2048, nt * 64, 64, kt * 64, WadaT, 1024, 6144 + nt * 64, smem); continue; }
    t -= 512;
    if (t < 128) {
      size_t e = (size_t)t * 2048 + tid * 8;
      const float* s = p.in[33] + e;
      float4 a = *(const float4*)s, b = *(const float4*)(s + 4);
      float v[8] = {a.x, a.y, a.z, a.w, b.x, b.y, b.z, b.w};
      store8bf(keysB + e, v);
      continue;
    }
    t -= 128;
    if (t < 128) {
      int e = t * 2048 + tid * 8;
      int r = e >> 10, c = e & 1023;
      float v[8];
      if (r < 136) {
        const float* s = (r < 8) ? (p.in[6] + r * 1024 + c) : (p.in[7] + (r - 8) * 1024 + c);
        float4 a = *(const float4*)s, b = *(const float4*)(s + 4);
        float w[8] = {a.x, a.y, a.z, a.w, b.x, b.y, b.z, b.w};
#pragma unroll
        for (int i = 0; i < 8; ++i) v[i] = siluf(w[i]);
      } else {
#pragma unroll
        for (int i = 0; i < 8; ++i) v[i] = 0.f;
      }
      store8bf(scb + e, v);
      continue;
    }
    t -= 128;
    {
      int e = t * 2048 + tid * 8;
      int b = e >> 12, r = (e >> 11) & 1, ch = e & 2047;
      const float* s = p.in[5] + ((size_t)(b * 3 + r + 1)) * 2048 + ch;
      float* d = p.out + O_CONV_S + ((size_t)(b * 3 + r)) * 2048 + ch;
      *(float4*)d = *(const float4*)s;
      *(float4*)(d + 4) = *(const float4*)(s + 4);
    }
  }
}

__device__ void phase_mod(const P& p, char* smem) {
  const bf16_t* scb = (const bf16_t*)(p.ws + OFF_SCB);
  const bf16_t* WadaT = (const bf16_t*)(p.ws + OFF_YS5);
  float* mod = (float*)(p.ws + OFF_MOD);
  float* modf = (float*)(p.ws + OFF_MODF);
  const float* b_ada = p.in[9];
  const float* b_adaf = p.in[38];
  {
    bf16_t* WinT = (bf16_t*)(p.ws + OFF_WINT);
    const int G = gridDim.x;
    const int nconv = (G > 128) ? (G - 128) : G;
    const int first = (G > 128) ? ((int)blockIdx.x - 128) : (int)blockIdx.x;
    if (first >= 0) {
      for (int t = first; t < 1472; t += nconv) {
        int nt = t >> 4, kt = t & 15, n0 = nt * 64, src, nv;
        if (n0 < 3584) { src = n0; nv = 64; }
        else if (n0 < 5632) { src = n0 + 16; nv = 64; }
        else if (n0 == 5632) { src = 3584; nv = 16; }
        else { src = 0; nv = 0; }
        tconv_tile(p.in[12], 5648, src, nv, kt * 64, WinT, 1024, n0, smem);
      }
    }
  }
  for (int tile = blockIdx.x; tile < 128; tile += gridDim.x) {
    int mt = tile & 1, nt = tile >> 1;
    f32x4 acc[4][4];
    zero_acc(acc);
    gemm_kloop(scb + (size_t)mt * 128 * 1024, 1024, WadaT + (size_t)nt * 128 * 1024, 1024, 1024, acc, smem);
    gemm_epilogue(acc, smem, mt * 128, nt * 128, [&](int row, int col, const float (&v)[8]) {
      if (row >= 136) return;
      if (col < 6144) {
        float* d = mod + (size_t)row * 6144 + col;
#pragma unroll
        for (int i = 0; i < 8; ++i) d[i] = v[i] + b_ada[col + i];
      } else {
        int c = col - 6144;
        float* d = modf + (size_t)row * 2048 + c;
#pragma unroll
        for (int i = 0; i < 8; ++i) d[i] = v[i] + b_adaf[c + i];
      }
    });
  }
}

__device__ void phase_norm(const P& p, int which) {
  const int lane = threadIdx.x & 63, wid = threadIdx.x >> 6;
  const float* mod = (const float*)(p.ws + OFF_MOD);
  const bf16_t* x1 = (const bf16_t*)(p.ws + OFF_XBC);
  bf16_t* hout = (bf16_t*)(p.ws + OFF_ACT);
  const float* g = which ? p.in[11] : p.in[10];
  for (int t = blockIdx.x * 4 + wid; t < TT; t += gridDim.x * 4) {
    const float* md = mod + (size_t)mrow(t) * 6144 + (which ? 3072 : 0);
    float v[16];
    if (which) {
      const bf16_t* xr = x1 + (size_t)t * 1024;
      uint4 a = *(const uint4*)(xr + lane * 8), c = *(const uint4*)(xr + 512 + lane * 8);
      float f0[8], f1[8];
      unpack8(a, f0); unpack8(c, f1);
#pragma unroll
      for (int i = 0; i < 8; ++i) { v[i] = f0[i]; v[8 + i] = f1[i]; }
    } else {
      const float* xr = (t < TP ? p.in[0] + (size_t)t * 1024 : p.in[1] + (size_t)(t - TP) * 1024);
      float4 a = *(const float4*)(xr + lane * 8), b = *(const float4*)(xr + lane * 8 + 4);
      float4 c = *(const float4*)(xr + 512 + lane * 8), d = *(const float4*)(xr + 512 + lane * 8 + 4);
      v[0] = a.x; v[1] = a.y; v[2] = a.z; v[3] = a.w; v[4] = b.x; v[5] = b.y; v[6] = b.z; v[7] = b.w;
      v[8] = c.x; v[9] = c.y; v[10] = c.z; v[11] = c.w; v[12] = d.x; v[13] = d.y; v[14] = d.z; v[15] = d.w;
    }
    float ss = 0.f;
#pragma unroll
    for (int i = 0; i < 16; ++i) ss += v[i] * v[i];
    ss = wave_sum(ss);
    float rs = rsqrtf(ss * (1.f / 1024.f) + 1e-6f);
#pragma unroll
    for (int hf = 0; hf < 2; ++hf) {
      int c0 = hf * 512 + lane * 8;
      float o[8];
#pragma unroll
      for (int i = 0; i < 8; ++i) {
        int c = c0 + i;
        o[i] = v[hf * 8 + i] * rs * g[c] * (1.f + md[1024 + c]) + md[c];
      }
      store8bf(hout + (size_t)t * 1024 + c0, o);
    }
  }
}

__device__ void phase_inproj(const P& p, char* smem) {
  const bf16_t* h = (const bf16_t*)(p.ws + OFF_ACT);
  const bf16_t* WinT = (const bf16_t*)(p.ws + OFF_WINT);
  bf16_t* u = (bf16_t*)(p.ws + OFF_U);
  bf16_t* z = (bf16_t*)(p.ws + OFF_Z);
  bf16_t* xbc = (bf16_t*)(p.ws + OFF_XBC);
  bf16_t* gates = (bf16_t*)(p.ws + OFF_GATES);
  float* dtb = (float*)(p.ws + OFF_DTB);
  const float* dt_bias = p.in[26];
  float* out = p.out;
  for (int tile = blockIdx.x; tile < 129 * 23; tile += gridDim.x) {
    const int mt = tile / 23, nt2 = tile % 23;
    f32x4 acc[4][8];
    zero_acc8(acc);
    gemm_kloop_n256(h + (size_t)mt * 128 * 1024, 1024, WinT + (size_t)nt2 * 256 * 1024, 1024, acc, smem);
    stage_all_bf16(acc, smem);
#pragma unroll 1
   for (int hh = 0; hh < 2; ++hh) {
    const int nt = nt2 * 2 + hh;
    if (nt >= 12 && nt < 28 && mt < 128) {
      const int tid = threadIdx.x;
      const bf16_t* Cs = (const bf16_t*)smem;
      const int c8 = (tid & 15) * 8;
      const int ch = nt * 128 - 1536 + c8;
      const int cc = hh * 128 + c8;
      const float* cw = p.in[24];
      const float* cbias = p.in[25];
      float wk[4][8], bias[8];
#pragma unroll
      for (int k = 0; k < 4; ++k) {
        float4 a = *(const float4*)(cw + k * 2048 + ch), b = *(const float4*)(cw + k * 2048 + ch + 4);
        wk[k][0] = a.x; wk[k][1] = a.y; wk[k][2] = a.z; wk[k][3] = a.w; wk[k][4] = b.x; wk[k][5] = b.y; wk[k][6] = b.z; wk[k][7] = b.w;
      }
      {
        float4 a = *(const float4*)(cbias + ch), b = *(const float4*)(cbias + ch + 4);
        bias[0] = a.x; bias[1] = a.y; bias[2] = a.z; bias[3] = a.w; bias[4] = b.x; bias[5] = b.y; bias[6] = b.z; bias[7] = b.w;
      }
      const bool seq_start = ((mt & 15) == 0);
      bf16_t* tails = (bf16_t*)(p.ws + OFF_TAILS);
#pragma unroll 1
      for (int i = 0; i < 8; ++i) {
        const int row = (tid >> 4) + 16 * i;
        const int grow = mt * 128 + row;
        float cur[8];
        cs16_load8(Cs, row, cc, cur);
        if (row >= 125) store8bf(tails + ((size_t)mt * 3 + (row - 125)) * 2048 + ch, cur);
        {
          const int l = grow & 2047;
          if (l >= 2045) {
            float* o = out + O_CONV_P + ((size_t)(grow >> 11) * 3 + (l - 2045)) * 2048 + ch;
            *(float4*)o = make_float4(cur[0], cur[1], cur[2], cur[3]);
            *(float4*)(o + 4) = make_float4(cur[4], cur[5], cur[6], cur[7]);
          }
        }
        if (row < 3 && !seq_start) {
          store8bf(xbc + (size_t)grow * 2048 + ch, cur);
        } else {
          float a[8];
#pragma unroll
          for (int q = 0; q < 8; ++q) a[q] = bias[q] + wk[3][q] * cur[q];
#pragma unroll
          for (int k = 0; k < 3; ++k) {
            const int rr = row - 3 + k;
            if (rr >= 0) {
              float pv[8];
              cs16_load8(Cs, rr, cc, pv);
#pragma unroll
              for (int q = 0; q < 8; ++q) a[q] += wk[k][q] * pv[q];
            }
          }
#pragma unroll
          for (int q = 0; q < 8; ++q) a[q] = siluf(a[q]);
          store8bf(xbc + (size_t)grow * 2048 + ch, a);
        }
      }
      continue;
    }
    epi_pass16(smem, hh, mt * 128, nt * 128, [&](int row, int col, const float (&v)[8]) {
      if (col < 512) {
        store8bf(u + (size_t)row * 512 + col, v);
      } else if (col < 1536) {
        store8bf(z + (size_t)row * 1024 + (col - 512), v);
      } else if (col < 3584) {
        int ch = col - 1536;
        store8bf(xbc + (size_t)row * 2048 + ch, v);
        float* o = nullptr;
        if (row >= TP) o = out + O_CONV_S + ((size_t)(row - TP) * 3 + 2) * 2048 + ch;
        else { int l = row & 2047; if (l >= 2045) o = out + O_CONV_P + ((size_t)(row >> 11) * 3 + (l - 2045)) * 2048 + ch; }
        if (o) { *(float4*)o = make_float4(v[0], v[1], v[2], v[3]); *(float4*)(o + 4) = make_float4(v[4], v[5], v[6], v[7]); }
      } else if (col < 5632) {
        float s[8];
#pragma unroll
        for (int i = 0; i < 8; ++i) s[i] = sigmf(v[i]);
        store8bf(gates + (size_t)row * 2048 + (col - 3584), s);
      } else if (col < 5648) {
#pragma unroll
        for (int i = 0; i < 8; ++i) {
          int hh = col - 5632 + i;
          float x = v[i] + dt_bias[hh];
          dtb[(size_t)row * 16 + hh] = (x > 20.f) ? x : log1pf(expf(x));
        }
      }
    });
   }
    __syncthreads();
  }
}

__device__ void phase_convfix(const P& p) {
  bf16_t* xbc = (bf16_t*)(p.ws + OFF_XBC);
  const bf16_t* tails = (const bf16_t*)(p.ws + OFF_TAILS);
  const float* cw = p.in[24];
  const float* cbias = p.in[25];
  const int ch = threadIdx.x * 8;
  for (int mt = blockIdx.x + 1; mt < 128; mt += gridDim.x) {
    if ((mt & 15) == 0) continue;
    float raw[6][8];
#pragma unroll
    for (int r = 0; r < 3; ++r) {
      uint4 a = *(const uint4*)(tails + ((size_t)(mt - 1) * 3 + r) * 2048 + ch);
      uint4 b = *(const uint4*)(xbc + ((size_t)mt * 128 + r) * 2048 + ch);
      unpack8(a, raw[r]); unpack8(b, raw[3 + r]);
    }
    float wk[4][8], bias[8];
#pragma unroll
    for (int k = 0; k < 4; ++k) {
      float4 a = *(const float4*)(cw + k * 2048 + ch), b = *(const float4*)(cw + k * 2048 + ch + 4);
      wk[k][0] = a.x; wk[k][1] = a.y; wk[k][2] = a.z; wk[k][3] = a.w; wk[k][4] = b.x; wk[k][5] = b.y; wk[k][6] = b.z; wk[k][7] = b.w;
    }
    {
      float4 a = *(const float4*)(cbias + ch), b = *(const float4*)(cbias + ch + 4);
      bias[0] = a.x; bias[1] = a.y; bias[2] = a.z; bias[3] = a.w; bias[4] = b.x; bias[5] = b.y; bias[6] = b.z; bias[7] = b.w;
    }
#pragma unroll
    for (int r = 0; r < 3; ++r) {
      float o[8];
#pragma unroll
      for (int q = 0; q < 8; ++q)
        o[q] = siluf(bias[q] + wk[0][q] * raw[r][q] + wk[1][q] * raw[r + 1][q] + wk[2][q] * raw[r + 2][q] + wk[3][q] * raw[r + 3][q]);
      store8bf(xbc + ((size_t)mt * 128 + r) * 2048 + ch, o);
    }
  }
}

__device__ void ssd_prompt_item(const P& p, char* smem, int b, int h) {
  const int tid = threadIdx.x, lane = tid & 63, w = tid >> 6, fr = lane & 15, fq = lane >> 4;
  const int g = h >> 2;
  bf16_t* Cm = (bf16_t*)(smem);
  bf16_t* Bm = (bf16_t*)(smem + 17408);
  bf16_t* Wb = Bm;
  bf16_t* BmT = (bf16_t*)(smem + 34816);
  bf16_t* XT = (bf16_t*)(smem + 53248);
  bf16_t* Hp = (bf16_t*)(smem + 62464);
  float* dts = (float*)(smem + 79872);
  float* css = (float*)(smem + 80128);
  const bf16_t* xbc = (const bf16_t*)(p.ws + OFF_XBC);
  const bf16_t* zb = (const bf16_t*)(p.ws + OFF_Z);
  const float* dtb = (const float*)(p.ws + OFF_DTB);
  bf16_t* yssd = (bf16_t*)(p.ws + OFF_YSSD);
  const float a_h = -expf(p.in[27][h]);
  const float Dh = p.in[28][h];
  for (int i = tid; i < 64 * 136 / 2; i += 256) ((unsigned*)Hp)[i] = 0u;
  f32x4 st[8];
#pragma unroll
  for (int n = 0; n < 8; ++n) st[n] = f32x4{0.f, 0.f, 0.f, 0.f};
  __syncthreads();
  const int xc4 = tid & 15, xj0 = (tid >> 4) * 4;
  const int bc4a = tid & 31, bj0a = (tid >> 5) * 4;
  const int bj0b = bj0a + 32;
  uint2 px[4], pb0[4], pb1[4], pc0[4], pc1[4];
  float pdt = 0.f;
  auto issue_loads = [&](int c) __attribute__((always_inline)) {
    const size_t r0 = (size_t)(b * 2048 + c * 64);
#pragma unroll
    for (int r = 0; r < 4; ++r) {
      px[r] = *(const uint2*)(xbc + (r0 + xj0 + r) * 2048 + h * 64 + xc4 * 4);
      pb0[r] = *(const uint2*)(xbc + (r0 + bj0a + r) * 2048 + 1024 + g * 128 + bc4a * 4);
      pb1[r] = *(const uint2*)(xbc + (r0 + bj0b + r) * 2048 + 1024 + g * 128 + bc4a * 4);
      pc0[r] = *(const uint2*)(xbc + (r0 + bj0a + r) * 2048 + 1536 + g * 128 + bc4a * 4);
      pc1[r] = *(const uint2*)(xbc + (r0 + bj0b + r) * 2048 + 1536 + g * 128 + bc4a * 4);
    }
    if (w == 0) pdt = dtb[(r0 + lane) * 16 + h];
  };
  issue_loads(0);
#pragma unroll 1
  for (int c = 0; c < 32; ++c) {
    const int t0 = b * 2048 + c * 64;
    if (w == 0) {
      float dt = pdt;
      float s = wave_incl_scan(dt * a_h);
      dts[lane] = dt;
      css[lane] = s;
    }
    __syncthreads();
    const float cs_last = css[63];
    {
      *(uint2*)(XT + (xc4 * 4 + 0) * 72 + xj0) = make_uint2((px[0].x & 0xffffu) | (px[1].x << 16), (px[2].x & 0xffffu) | (px[3].x << 16));
      *(uint2*)(XT + (xc4 * 4 + 1) * 72 + xj0) = make_uint2((px[0].x >> 16) | (px[1].x & 0xffff0000u), (px[2].x >> 16) | (px[3].x & 0xffff0000u));
      *(uint2*)(XT + (xc4 * 4 + 2) * 72 + xj0) = make_uint2((px[0].y & 0xffffu) | (px[1].y << 16), (px[2].y & 0xffffu) | (px[3].y << 16));
      *(uint2*)(XT + (xc4 * 4 + 3) * 72 + xj0) = make_uint2((px[0].y >> 16) | (px[1].y & 0xffff0000u), (px[2].y >> 16) | (px[3].y & 0xffff0000u));
#pragma unroll
      for (int r = 0; r < 4; ++r) {
        *(uint2*)(Bm + (bj0a + r) * 136 + bc4a * 4) = pb0[r];
        *(uint2*)(Bm + (bj0b + r) * 136 + bc4a * 4) = pb1[r];
        *(uint2*)(Cm + (bj0a + r) * 136 + bc4a * 4) = pc0[r];
        *(uint2*)(Cm + (bj0b + r) * 136 + bc4a * 4) = pc1[r];
      }
      float sa[4], sb[4];
#pragma unroll
      for (int r = 0; r < 4; ++r) {
        sa[r] = dts[bj0a + r] * __expf(cs_last - css[bj0a + r]);
        sb[r] = dts[bj0b + r] * __expf(cs_last - css[bj0b + r]);
      }
      *(uint2*)(BmT + (bc4a * 4 + 0) * 72 + bj0a) = make_uint2(cvtpk(bflo(pb0[0].x) * sa[0], bflo(pb0[1].x) * sa[1]), cvtpk(bflo(pb0[2].x) * sa[2], bflo(pb0[3].x) * sa[3]));
      *(uint2*)(BmT + (bc4a * 4 + 1) * 72 + bj0a) = make_uint2(cvtpk(bfhi(pb0[0].x) * sa[0], bfhi(pb0[1].x) * sa[1]), cvtpk(bfhi(pb0[2].x) * sa[2], bfhi(pb0[3].x) * sa[3]));
      *(uint2*)(BmT + (bc4a * 4 + 2) * 72 + bj0a) = make_uint2(cvtpk(bflo(pb0[0].y) * sa[0], bflo(pb0[1].y) * sa[1]), cvtpk(bflo(pb0[2].y) * sa[2], bflo(pb0[3].y) * sa[3]));
      *(uint2*)(BmT + (bc4a * 4 + 3) * 72 + bj0a) = make_uint2(cvtpk(bfhi(pb0[0].y) * sa[0], bfhi(pb0[1].y) * sa[1]), cvtpk(bfhi(pb0[2].y) * sa[2], bfhi(pb0[3].y) * sa[3]));
      *(uint2*)(BmT + (bc4a * 4 + 0) * 72 + bj0b) = make_uint2(cvtpk(bflo(pb1[0].x) * sb[0], bflo(pb1[1].x) * sb[1]), cvtpk(bflo(pb1[2].x) * sb[2], bflo(pb1[3].x) * sb[3]));
      *(uint2*)(BmT + (bc4a * 4 + 1) * 72 + bj0b) = make_uint2(cvtpk(bfhi(pb1[0].x) * sb[0], bfhi(pb1[1].x) * sb[1]), cvtpk(bfhi(pb1[2].x) * sb[2], bfhi(pb1[3].x) * sb[3]));
      *(uint2*)(BmT + (bc4a * 4 + 2) * 72 + bj0b) = make_uint2(cvtpk(bflo(pb1[0].y) * sb[0], bflo(pb1[1].y) * sb[1]), cvtpk(bflo(pb1[2].y) * sb[2], bflo(pb1[3].y) * sb[3]));
      *(uint2*)(BmT + (bc4a * 4 + 3) * 72 + bj0b) = make_uint2(cvtpk(bfhi(pb1[0].y) * sb[0], bfhi(pb1[1].y) * sb[1]), cvtpk(bfhi(pb1[2].y) * sb[2], bfhi(pb1[3].y) * sb[3]));
    }
    if (c + 1 < 32) issue_loads(c + 1);
    __syncthreads();
    f32x4 cbv[4];
#pragma unroll
    for (int jt = 0; jt < 4; ++jt) cbv[jt] = f32x4{0.f, 0.f, 0.f, 0.f};
#pragma unroll
    for (int ks = 0; ks < 4; ++ks) {
      bf16x8 a = *(const bf16x8*)(Cm + (16 * w + fr) * 136 + ks * 32 + fq * 8);
#pragma unroll
      for (int jt = 0; jt < 4; ++jt) {
        bf16x8 bb = *(const bf16x8*)(Bm + (jt * 16 + fr) * 136 + ks * 32 + fq * 8);
        cbv[jt] = __builtin_amdgcn_mfma_f32_16x16x32_bf16(a, bb, cbv[jt], 0, 0, 0);
      }
    }
    __syncthreads();
#pragma unroll
    for (int jt = 0; jt < 4; ++jt)
#pragma unroll
      for (int r = 0; r < 4; ++r) {
        int i = 16 * w + 4 * fq + r, j = jt * 16 + fr;
        float val = 0.f;
        if (j <= i) val = cbv[jt][r] * __expf(css[i] - css[j]) * dts[j];
        Wb[i * 72 + j] = f2bf(val);
      }
    __syncthreads();
    {
      f32x4 yd[4], yo[4];
#pragma unroll
      for (int mt = 0; mt < 4; ++mt) { yd[mt] = f32x4{0.f, 0.f, 0.f, 0.f}; yo[mt] = f32x4{0.f, 0.f, 0.f, 0.f}; }
#pragma unroll
      for (int ks = 0; ks < 2; ++ks) {
        bf16x8 bb = *(const bf16x8*)(XT + (16 * w + fr) * 72 + ks * 32 + fq * 8);
#pragma unroll
        for (int mt = 0; mt < 4; ++mt) {
          bf16x8 a = *(const bf16x8*)(Wb + (mt * 16 + fr) * 72 + ks * 32 + fq * 8);
          yd[mt] = __builtin_amdgcn_mfma_f32_16x16x32_bf16(a, bb, yd[mt], 0, 0, 0);
        }
      }
#pragma unroll
      for (int ks = 0; ks < 4; ++ks) {
        bf16x8 bb = *(const bf16x8*)(Hp + (16 * w + fr) * 136 + ks * 32 + fq * 8);
#pragma unroll
        for (int mt = 0; mt < 4; ++mt) {
          bf16x8 a = *(const bf16x8*)(Cm + (mt * 16 + fr) * 136 + ks * 32 + fq * 8);
          yo[mt] = __builtin_amdgcn_mfma_f32_16x16x32_bf16(a, bb, yo[mt], 0, 0, 0);
        }
      }
      const int pp = 16 * w + fr;
#pragma unroll
      for (int mt = 0; mt < 4; ++mt)
#pragma unroll
        for (int r = 0; r < 4; ++r) {
          int i = mt * 16 + 4 * fq + r;
          float yv = yd[mt][r] + __expf(css[i]) * yo[mt][r] + Dh * bf2f(XT[pp * 72 + i]);
          size_t off = (size_t)(t0 + i) * 1024 + h * 64 + pp;
          yssd[off] = f2bf(yv);
        }
    }
    {
      const float dec = __expf(cs_last);
#pragma unroll
      for (int n = 0; n < 8; ++n) { st[n][0] *= dec; st[n][1] *= dec; st[n][2] *= dec; st[n][3] *= dec; }
#pragma unroll
      for (int ks = 0; ks < 2; ++ks) {
        bf16x8 a = *(const bf16x8*)(XT + (16 * w + fr) * 72 + ks * 32 + fq * 8);
#pragma unroll
        for (int n = 0; n < 8; ++n) {
          bf16x8 bb = *(const bf16x8*)(BmT + (n * 16 + fr) * 72 + ks * 32 + fq * 8);
          st[n] = __builtin_amdgcn_mfma_f32_16x16x32_bf16(a, bb, st[n], 0, 0, 0);
        }
      }
#pragma unroll
      for (int n = 0; n < 8; ++n)
#pragma unroll
        for (int r = 0; r < 4; ++r) Hp[(16 * w + 4 * fq + r) * 136 + n * 16 + fr] = f2bf(st[n][r]);
    }
    __syncthreads();
  }
  float* so = p.out + O_SSM_P + ((size_t)(b * 16 + h) * 64) * 128;
#pragma unroll
  for (int n = 0; n < 8; ++n)
#pragma unroll
    for (int r = 0; r < 4; ++r) so[(size_t)(16 * w + 4 * fq + r) * 128 + n * 16 + fr] = st[n][r];
}

struct S5Par { float ar, ai; };
DI void s5_abar(const P& p, int g, int pp, float& abr, float& abi, float& fre, float& fim) {
  float dt = expf(p.in[15][g]);
  float ar = p.in[13][g * 64 + pp], ai = p.in[14][g * 64 + pp];
  float mag = expf(dt * ar);
  float sn, cs;
  sincosf(dt * ai, &sn, &cs);
  abr = mag * cs; abi = mag * sn;
  float den = ar * ar + ai * ai;
  float nr = abr - 1.f;
  fre = (nr * ar + abi * ai) / den;
  fim = (abi * ar - nr * ai) / den;
}

__device__ void s5_prompt_item(const P& p, char* smem, int b, int g4) {
  const int tid = threadIdx.x, lane = tid & 63, w = tid >> 6;
  const int g = g4 * 4 + w;
  const int r31 = lane & 31, hh = lane >> 5, fr = lane & 15, fq = lane >> 4;
  bf16_t* Sl = (bf16_t*)(smem + w * 8704);
  const bf16_t* ub = (const bf16_t*)(p.ws + OFF_U);
  bf16_t* ys5 = (bf16_t*)(p.ws + OFF_YS5);
  float a1r[2], a1i[2], a2r[2], a2i[2], a3r[2], a3i[2], a4r[2], a4i[2];
  bf16x8 bfrag[4];
#pragma unroll
  for (int pi = 0; pi < 2; ++pi) {
    int pp = pi * 32 + r31;
    float fre, fim;
    s5_abar(p, g, pp, a1r[pi], a1i[pi], fre, fim);
    a2r[pi] = a1r[pi] * a1r[pi] - a1i[pi] * a1i[pi]; a2i[pi] = 2.f * a1r[pi] * a1i[pi];
    a3r[pi] = a2r[pi] * a1r[pi] - a2i[pi] * a1i[pi]; a3i[pi] = a2r[pi] * a1i[pi] + a2i[pi] * a1r[pi];
    a4r[pi] = a2r[pi] * a2r[pi] - a2i[pi] * a2i[pi]; a4i[pi] = 2.f * a2r[pi] * a2i[pi];
    const float* br = p.in[16] + ((size_t)(g * 64 + pp)) * 16 + hh * 8;
    const float* bi = p.in[17] + ((size_t)(g * 64 + pp)) * 16 + hh * 8;
    float vr[8], vi[8];
#pragma unroll
    for (int j = 0; j < 8; ++j) {
      vr[j] = fre * br[j] - fim * bi[j];
      vi[j] = fre * bi[j] + fim * br[j];
    }
    bfrag[pi] = mk8(cvtpk(vr[0], vr[1]), cvtpk(vr[2], vr[3]), cvtpk(vr[4], vr[5]), cvtpk(vr[6], vr[7]));
    bfrag[2 + pi] = mk8(cvtpk(vi[0], vi[1]), cvtpk(vi[2], vi[3]), cvtpk(vi[4], vi[5]), cvtpk(vi[6], vi[7]));
  }
  bf16x8 cfrag[4];
#pragma unroll
  for (int ks = 0; ks < 4; ++ks) {
    int k0 = 32 * ks + 8 * fq;
    float v[8];
#pragma unroll
    for (int j = 0; j < 8; ++j) {
      int k = k0 + j;
      v[j] = (k < 64) ? p.in[18][((size_t)(g * 16 + fr)) * 64 + k] : -p.in[19][((size_t)(g * 16 + fr)) * 64 + (k - 64)];
    }
    cfrag[ks] = mk8(cvtpk(v[0], v[1]), cvtpk(v[2], v[3]), cvtpk(v[4], v[5]), cvtpk(v[6], v[7]));
  }
  const float dsk = p.in[20][g * 16 + fr];
  float Sr[2] = {0.f, 0.f}, Si[2] = {0.f, 0.f};
  const size_t tbase = (size_t)b * 2048;
  bf16x8 afr_n = *(const bf16x8*)(ub + (tbase + r31) * 512 + g * 16 + hh * 8);
  bf16_t uv_n[8];
#pragma unroll
  for (int q = 0; q < 8; ++q) uv_n[q] = ub[(tbase + (q >> 2) * 16 + 4 * fq + (q & 3)) * 512 + g * 16 + fr];
#pragma unroll 1
  for (int c = 0; c < 64; ++c) {
    const size_t t0 = tbase + c * 32;
    const bf16x8 afr = afr_n;
    bf16_t uv_c[8];
#pragma unroll
    for (int q = 0; q < 8; ++q) uv_c[q] = uv_n[q];
    if (c + 1 < 64) {
      afr_n = *(const bf16x8*)(ub + (t0 + 32 + r31) * 512 + g * 16 + hh * 8);
#pragma unroll
      for (int q = 0; q < 8; ++q) uv_n[q] = ub[(t0 + 32 + (q >> 2) * 16 + 4 * fq + (q & 3)) * 512 + g * 16 + fr];
    }
    f32x16 acc[4];
#pragma unroll
    for (int ct = 0; ct < 4; ++ct) {
#pragma unroll
      for (int q = 0; q < 16; ++q) acc[ct][q] = 0.f;
      acc[ct] = __builtin_amdgcn_mfma_f32_32x32x16_bf16(afr, bfrag[ct], acc[ct], 0, 0, 0);
    }
#pragma unroll
    for (int pi = 0; pi < 2; ++pi) {
      float sre[16], sim[16];
#pragma unroll
      for (int q = 0; q < 16; ++q) { sre[q] = acc[pi][q]; sim[q] = acc[2 + pi][q]; }
#pragma unroll
      for (int k = 0; k < 4; ++k)
#pragma unroll
        for (int i = 1; i < 4; ++i) {
          int q = 4 * k + i;
          float nr = sre[q] + a1r[pi] * sre[q - 1] - a1i[pi] * sim[q - 1];
          float ni = sim[q] + a1r[pi] * sim[q - 1] + a1i[pi] * sre[q - 1];
          sre[q] = nr; sim[q] = ni;
        }
      float Pr[4], Pi[4];
#pragma unroll
      for (int k = 0; k < 4; ++k) { Pr[k] = __shfl_xor(sre[4 * k + 3], 32); Pi[k] = __shfl_xor(sim[4 * k + 3], 32); }
      float cr = Sr[pi], ci = Si[pi];
      float cinr[4], cini[4];
#pragma unroll
      for (int G = 0; G < 8; ++G) {
        const int k = G >> 1;
        const bool mine = ((G & 1) == hh);
        if ((G & 1) == 0) { cinr[k] = cr; cini[k] = ci; }
        else { cinr[k] = mine ? cr : cinr[k]; cini[k] = mine ? ci : cini[k]; }
        float fr_ = mine ? sre[4 * k + 3] : Pr[k];
        float fi_ = mine ? sim[4 * k + 3] : Pi[k];
        float nr = a4r[pi] * cr - a4i[pi] * ci + fr_;
        float ni = a4r[pi] * ci + a4i[pi] * cr + fi_;
        cr = nr; ci = ni;
      }
      Sr[pi] = cr; Si[pi] = ci;
#pragma unroll
      for (int k = 0; k < 4; ++k) {
        const float pwr[4] = {a1r[pi], a2r[pi], a3r[pi], a4r[pi]};
        const float pwi[4] = {a1i[pi], a2i[pi], a3i[pi], a4i[pi]};
#pragma unroll
        for (int i = 0; i < 4; ++i) {
          int q = 4 * k + i;
          float vr = sre[q] + pwr[i] * cinr[k] - pwi[i] * cini[k];
          float vi = sim[q] + pwr[i] * cini[k] + pwi[i] * cinr[k];
          int tok = i + 8 * k + 4 * hh;
          Sl[tok * 136 + pi * 32 + r31] = f2bf(vr);
          Sl[tok * 136 + 64 + pi * 32 + r31] = f2bf(vi);
        }
      }
    }
    __syncthreads();
    f32x4 yacc[2];
#pragma unroll
    for (int mt = 0; mt < 2; ++mt) {
      yacc[mt] = f32x4{0.f, 0.f, 0.f, 0.f};
#pragma unroll
      for (int ks = 0; ks < 4; ++ks) {
        bf16x8 a = *(const bf16x8*)(Sl + (mt * 16 + fr) * 136 + ks * 32 + fq * 8);
        yacc[mt] = __builtin_amdgcn_mfma_f32_16x16x32_bf16(a, cfrag[ks], yacc[mt], 0, 0, 0);
      }
    }
#pragma unroll
    for (int mt = 0; mt < 2; ++mt)
#pragma unroll
      for (int r = 0; r < 4; ++r) {
        int tok = mt * 16 + 4 * fq + r;
        size_t off = (t0 + tok) * 512 + g * 16 + fr;
        float uv = bf2f(uv_c[mt * 4 + r]);
        ys5[off] = f2bf(geluf(yacc[mt][r] + dsk * uv));
      }
    __syncthreads();
  }
  if (hh == 0) {
#pragma unroll
    for (int pi = 0; pi < 2; ++pi) {
      p.out[O_S5RE_P + (size_t)(b * 32 + g) * 64 + pi * 32 + r31] = Sr[pi];
      p.out[O_S5IM_P + (size_t)(b * 32 + g) * 64 + pi * 32 + r31] = Si[pi];
    }
  }
}

__device__ void s5_sample_item(const P& p, int item) {
  const int lane = threadIdx.x & 63, w = threadIdx.x >> 6;
  const bf16_t* ub = (const bf16_t*)(p.ws + OFF_U);
  bf16_t* ys5 = (bf16_t*)(p.ws + OFF_YS5);
  const int b = item >> 3;
  const int g = (item & 7) * 4 + w;
  const size_t t = TP + b;
  float abr, abi, fre, fim;
  s5_abar(p, g, lane, abr, abi, fre, fim);
  float uv[16];
  {
    uint4 u0 = *(const uint4*)(ub + t * 512 + g * 16), u1 = *(const uint4*)(ub + t * 512 + g * 16 + 8);
    float t0[8], t1[8];
    unpack8(u0, t0); unpack8(u1, t1);
#pragma unroll
    for (int i = 0; i < 8; ++i) { uv[i] = t0[i]; uv[8 + i] = t1[i]; }
  }
  float cr[16], cm[16], dsk[16];
#pragma unroll
  for (int hx = 0; hx < 16; ++hx) {
    cr[hx] = p.in[18][((size_t)(g * 16 + hx)) * 64 + lane];
    cm[hx] = p.in[19][((size_t)(g * 16 + hx)) * 64 + lane];
    dsk[hx] = p.in[20][g * 16 + hx];
  }
  const float* br = p.in[16] + ((size_t)(g * 64 + lane)) * 16;
  const float* bi = p.in[17] + ((size_t)(g * 64 + lane)) * 16;
  float bur = 0.f, bui = 0.f;
#pragma unroll
  for (int hx = 0; hx < 16; ++hx) {
    float bbr = fre * br[hx] - fim * bi[hx];
    float bbi = fre * bi[hx] + fim * br[hx];
    bur += bbr * uv[hx]; bui += bbi * uv[hx];
  }
  float s0r = p.in[2][((size_t)b * 32 + g) * 64 + lane], s0i = p.in[3][((size_t)b * 32 + g) * 64 + lane];
  float sr = abr * s0r - abi * s0i + bur;
  float si = abr * s0i + abi * s0r + bui;
  p.out[O_S5RE_S + ((size_t)b * 32 + g) * 64 + lane] = sr;
  p.out[O_S5IM_S + ((size_t)b * 32 + g) * 64 + lane] = si;
  float myy = 0.f;
#pragma unroll
  for (int hx = 0; hx < 16; ++hx) {
    float v = wave_sum_fast(cr[hx] * sr - cm[hx] * si);
    if (lane == hx) myy = v + dsk[hx] * uv[hx];
  }
  if (lane < 16) ys5[t * 512 + g * 16 + lane] = f2bf(geluf(myy));
}

__device__ void ssd_sample_item(const P& p, char* smem, int b, int g) {
  const int tid = threadIdx.x, lane = tid & 63, w = tid >> 6;
  float* xs = (float*)smem;
  float* Bs = xs + 256;
  float* Cs = Bs + 128;
  float* ybuf = Cs + 128;
  float* red = ybuf + 256;
  const size_t t = TP + b;
  const bf16_t* xbc = (const bf16_t*)(p.ws + OFF_XBC);
  const bf16_t* zb = (const bf16_t*)(p.ws + OFF_Z);
  const float* dtb = (const float*)(p.ws + OFF_DTB);
  bf16_t* yb = (bf16_t*)(p.ws + OFF_YSSD);
  const float* cw = p.in[24];
  const float* cbias = p.in[25];
  const float* sconv = p.in[5] + (size_t)b * 3 * 2048;
  {
#pragma unroll
    for (int part = 0; part < 2; ++part) {
      int ch = part == 0 ? (g * 256 + tid) : (tid < 128 ? 1024 + g * 128 + tid : 1536 + g * 128 + (tid - 128));
      float a = cbias[ch] + cw[ch] * sconv[ch] + cw[2048 + ch] * sconv[2048 + ch] + cw[4096 + ch] * sconv[4096 + ch]
                + cw[6144 + ch] * bf2f(xbc[t * 2048 + ch]);
      a = siluf(a);
      if (part == 0) xs[tid] = a; else Bs[tid] = a;
    }
  }
  __syncthreads();
  const int h = g * 4 + w;
  const float dt = dtb[t * 16 + h];
  const float a_h = -expf(p.in[27][h]);
  const float dA = __expf(dt * a_h);
  const float* h0 = p.in[4] + ((size_t)(b * 16 + h) * 64) * 128;
  float* hn = p.out + O_SSM_S + ((size_t)(b * 16 + h) * 64) * 128;
  const int n4 = (lane & 31) * 4;
  const float4 Bv = *(const float4*)(Bs + n4);
  const float4 Cv = *(const float4*)(Cs + n4);
#pragma unroll 4
  for (int it = 0; it < 32; ++it) {
    int pp = 2 * it + (lane >> 5);
    float4 hv = *(const float4*)(h0 + (size_t)pp * 128 + n4);
    float xd = dt * xs[w * 64 + pp];
    float4 nv;
    nv.x = dA * hv.x + xd * Bv.x; nv.y = dA * hv.y + xd * Bv.y; nv.z = dA * hv.z + xd * Bv.z; nv.w = dA * hv.w + xd * Bv.w;
    *(float4*)(hn + (size_t)pp * 128 + n4) = nv;
    float part = Cv.x * nv.x + Cv.y * nv.y + Cv.z * nv.z + Cv.w * nv.w;
#pragma unroll
    for (int o = 16; o; o >>= 1) part += __shfl_xor(part, o);
    if ((lane & 31) == 0) ybuf[w * 64 + pp] = part;
  }
  __syncthreads();
  float y = ybuf[tid] + p.in[28][g * 4 + (tid >> 6)] * xs[tid];
  float zv = bf2f(zb[t * 1024 + g * 256 + tid]);
  y *= siluf(zv);
  float ss = wave_sum(y * y);
  if (lane == 0) red[w] = ss;
  __syncthreads();
  float tot = red[0] + red[1] + red[2] + red[3];
  float rs = rsqrtf(tot * (1.f / 256.f) + 1e-5f);
  yb[t * 1024 + g * 256 + tid] = f2bf(y * rs * p.in[29][g * 256 + tid]);
  __syncthreads();
}

__device__ void expert_convert_dynamic(const P& p, char* smem) {
  unsigned char* E8 = (unsigned char*)(p.ws + OFF_E8);
  float* Esc = (float*)(p.ws + OFF_E8 + 33554432);
  unsigned* counter = (unsigned*)(p.ws + OFF_BAR + 14336);
  const int tid = threadIdx.x, lane = tid & 63, wid = tid >> 6;
  int* stask = (int*)(smem + 64);
  for (;;) {
    __syncthreads();
    if (tid == 0) *stask = (int)atomicAdd(counter, 1u);
    __syncthreads();
    const int q = *stask;
    if (q >= 2048) break;
    const int tbl = (q >= 1024) ? 1 : 0;
    const float* src = tbl ? p.in[35] : p.in[34];
    const int row0 = (q & 1023) * 16 + wid * 4;
    float4 ld[4][4];
#pragma unroll
    for (int r = 0; r < 4; ++r) {
      const float* sp = src + (size_t)(row0 + r) * 1024 + lane * 16;
#pragma unroll
      for (int k = 0; k < 4; ++k) ld[r][k] = *(const float4*)(sp + 4 * k);
    }
#pragma unroll
    for (int r = 0; r < 4; ++r) {
      float am = 0.f;
#pragma unroll
      for (int k = 0; k < 4; ++k)
        am = fmaxf(am, fmaxf(fmaxf(fabsf(ld[r][k].x), fabsf(ld[r][k].y)), fmaxf(fabsf(ld[r][k].z), fabsf(ld[r][k].w))));
      am = wave_max(am);
      const float sc = (am > 0.f) ? am * (1.f / 448.f) : 1.f;
      const float inv = 1.f / sc;
      unsigned w[4];
#pragma unroll
      for (int k = 0; k < 4; ++k) {
        int t0 = __builtin_amdgcn_cvt_pk_fp8_f32(ld[r][k].x * inv, ld[r][k].y * inv, 0, false);
        t0 = __builtin_amdgcn_cvt_pk_fp8_f32(ld[r][k].z * inv, ld[r][k].w * inv, t0, true);
        w[k] = (unsigned)t0;
      }
      const int rowi = row0 + r;
      *(uint4*)(E8 + (size_t)tbl * 16777216 + (size_t)rowi * 1024 + lane * 16) = make_uint4(w[0], w[1], w[2], w[3]);
      if (lane == 0) Esc[tbl * 16384 + rowi] = sc;
    }
  }
  __syncthreads();
}

__device__ void late_weight_convert(const P& p, char* smem) {
  bf16_t* WgluT = (bf16_t*)(p.ws + OFF_WGLUT);
  bf16_t* WaT = (bf16_t*)(p.ws + OFF_WAT);
  bf16_t* WbT = (bf16_t*)(p.ws + OFF_WBT);
  bf16_t* WoutT = (bf16_t*)(p.ws + OFF_WOUTT);
  bf16_t* WqT = (bf16_t*)(p.ws + OFF_WQT);
  unsigned* counter = (unsigned*)(p.ws + OFF_BAR + 14400);
  int* stask = (int*)(smem + 20480);
  for (;;) {
    __syncthreads();
    if (threadIdx.x == 0) *stask = (int)atomicAdd(counter, 1u);
    __syncthreads();
    int t = *stask;
    if (t >= 1216) break;
    if (t < 64) { int nt = t >> 3, kt = t & 7; tconv_tile(p.in[21], 512, nt * 64, 64, kt * 64, WgluT, 512, nt * 64, smem); continue; }
    t -= 64;
    if (t < 128) { int nt = t >> 3, kt = t & 7; tconv_tile(p.in[23], 1024, nt * 64, 64, kt * 64, WaT, 512, nt * 64, smem); continue; }
    t -= 128;
    if (t < 256) { int nt = t >> 4, kt = t & 15; tconv_tile(p.in[30], 1024, nt * 64, 64, kt * 64, WbT, 1024, nt * 64, smem); continue; }
    t -= 256;
    if (t < 256) { int nt = t >> 4, kt = t & 15; tconv_tile(p.in[31], 1024, nt * 64, 64, kt * 64, WoutT, 1024, nt * 64, smem); continue; }
    t -= 256;
    { int nt = t >> 4, kt = t & 15; tconv_tile(p.in[32], 2048, nt * 64, 64, kt * 64, WqT, 1024, nt * 64, smem); }
  }
  __syncthreads();
}

__device__ void phase_mixers(const P& p, char* smem) {
  const int G = gridDim.x;
#pragma unroll 1
  for (int it = blockIdx.x; it < 128; it += G) { ssd_prompt_item(p, smem, it >> 4, it & 15); __syncthreads(); }
#pragma unroll 1
  for (int it = (blockIdx.x + G - 128 % G) % G; it < 64; it += G) { s5_prompt_item(p, smem, it >> 3, it & 7); __syncthreads(); }
  const bool wide = (G >= 512);
  const int bid = (int)blockIdx.x;
  const int wi = (bid >= 192 && bid < 256) ? bid - 192 : ((bid >= 384) ? bid - 384 + 64 : -1);
  const int nw = G - 320;
  const int ss_start = wide ? (wi >= 0 ? wi : 512) : (int)((blockIdx.x + G - 192 % G) % G);
  const int ss_step = wide ? nw : G;
#pragma unroll 1
  for (int it = ss_start; it < 512; it += ss_step) { ssd_sample_item(p, smem, it >> 2, it & 3); __syncthreads(); }
  const int s5s_start = wide ? (wi >= 0 ? wi : 1024) : (int)((blockIdx.x + G - 704 % G) % G);
#pragma unroll 1
  for (int it = s5s_start; it < 1024; it += ss_step) { s5_sample_item(p, it); __syncthreads(); }
  if (wide && bid >= 256 && bid < 384) return;
  late_weight_convert(p, smem);
  expert_convert_dynamic(p, smem);
}

__device__ void phase_glu(const P& p, char* smem) {
  const bf16_t* ys5 = (const bf16_t*)(p.ws + OFF_YS5);
  const bf16_t* WgluT = (const bf16_t*)(p.ws + OFF_WGLUT);
  bf16_t* ya = (bf16_t*)(p.ws + OFF_U);
  bf16_t* yb = (bf16_t*)(p.ws + OFF_YSSD);
  const bf16_t* zb = (const bf16_t*)(p.ws + OFF_Z);
  const float* bglu = p.in[22];
  const float* gn = p.in[29];
  const int lane = threadIdx.x & 63, wid = threadIdx.x >> 6;
  const int NT = 516 + 1024;
  for (int task = blockIdx.x; task < NT; task += gridDim.x) {
    if (task < 516) {
      int mt = task >> 2, nt = task & 3;
      f32x4 acc[4][4];
      zero_acc(acc);
      gemm_kloop(ys5 + (size_t)mt * 128 * 512, 512, WgluT + (size_t)nt * 128 * 512, 512, 512, acc, smem);
      gemm_epilogue(acc, smem, mt * 128, nt * 128, [&](int row, int col, const float (&v)[8]) {
        uint4 yv = *(const uint4*)(ys5 + (size_t)row * 512 + col);
        float y[8], o[8];
        unpack8(yv, y);
#pragma unroll
        for (int i = 0; i < 8; ++i) o[i] = y[i] * sigmf(v[i] + bglu[col + i]);
        store8bf(ya + (size_t)row * 512 + col, o);
      });
    } else {
      int base = (task - 516) * 16;
#pragma unroll 1
      for (int q = 0; q < 4; ++q) {
        size_t t = base + q * 4 + wid;
        bf16_t* rowp = yb + t * 1024 + lane * 16;
        const bf16_t* zp = zb + t * 1024 + lane * 16;
        uint4 a = *(const uint4*)rowp, b = *(const uint4*)(rowp + 8);
        uint4 za = *(const uint4*)zp, zb2 = *(const uint4*)(zp + 8);
        float v0[8], v1[8], z0[8], z1[8];
        unpack8(a, v0); unpack8(b, v1); unpack8(za, z0); unpack8(zb2, z1);
#pragma unroll
        for (int i = 0; i < 8; ++i) { v0[i] *= siluf(z0[i]); v1[i] *= siluf(z1[i]); }
        float ss = 0.f;
#pragma unroll
        for (int i = 0; i < 8; ++i) ss += v0[i] * v0[i] + v1[i] * v1[i];
#pragma unroll
        for (int o = 8; o; o >>= 1) ss += __shfl_xor(ss, o);
        float rs = rsqrtf(ss * (1.f / 256.f) + 1e-5f);
        const float* gp = gn + lane * 16;
#pragma unroll
        for (int i = 0; i < 8; ++i) { v0[i] *= rs * gp[i]; v1[i] *= rs * gp[8 + i]; }
        store8bf(rowp, v0);
        store8bf(rowp + 8, v1);
      }
    }
  }
}

__device__ void phase_merge(const P& p, char* smem) {
  const bf16_t* ya = (const bf16_t*)(p.ws + OFF_U);
  const bf16_t* yb = (const bf16_t*)(p.ws + OFF_YSSD);
  const bf16_t* WaT = (const bf16_t*)(p.ws + OFF_WAT);
  const bf16_t* WbT = (const bf16_t*)(p.ws + OFF_WBT);
  const bf16_t* gates = (const bf16_t*)(p.ws + OFF_GATES);
  bf16_t* tmp = (bf16_t*)(p.ws + OFF_XBC);
  bf16_t* merged = (bf16_t*)(p.ws + OFF_ACT);
  auto epiA = [&](int row, int col, const float (&v)[8]) {
    uint4 gv = *(const uint4*)(gates + (size_t)row * 2048 + col);
    float gg[8];
    unpack8(gv, gg);
    float o[8];
#pragma unroll
    for (int i = 0; i < 8; ++i) o[i] = gg[i] * v[i];
    store8bf(tmp + (size_t)row * 1024 + col, o);
  };
  auto epiB = [&](int row, int col, const float (&v)[8]) {
    uint4 gv = *(const uint4*)(gates + (size_t)row * 2048 + 1024 + col);
    float gg[8], o[8];
    unpack8(gv, gg);
    uint4 tv = *(const uint4*)(tmp + (size_t)row * 1024 + col);
    float tf[8];
    unpack8(tv, tf);
#pragma unroll
    for (int i = 0; i < 8; ++i) o[i] = tf[i] + gg[i] * v[i];
    store8bf(merged + (size_t)row * 1024 + col, o);
  };
#pragma unroll 1
  for (int tile = blockIdx.x; tile < 512; tile += gridDim.x) {
    const int mt = tile >> 2, nt2 = tile & 3;
    f32x4 acc[4][8];
    zero_acc8(acc);
    gemm_kloop_n256(ya + (size_t)mt * 128 * 512, 512, WaT + (size_t)nt2 * 256 * 512, 512, acc, smem);
    stage_all_bf16(acc, smem);
#pragma unroll 1
    for (int hh = 0; hh < 2; ++hh) epi_pass16(smem, hh, mt * 128, (nt2 * 2 + hh) * 128, epiA);
    __syncthreads();
  }
#pragma unroll 1
  for (int nt = blockIdx.x; nt < 8; nt += gridDim.x) {
    f32x4 acc[4][4];
    zero_acc(acc);
    gemm_kloop(ya + (size_t)TP * 512, 512, WaT + (size_t)nt * 128 * 512, 512, 512, acc, smem);
    gemm_epilogue(acc, smem, TP, nt * 128, epiA);
  }
#pragma unroll 1
  for (int tile = blockIdx.x; tile < 512; tile += gridDim.x) {
    const int mt = tile >> 2, nt2 = tile & 3;
    f32x4 acc[4][8];
    zero_acc8(acc);
    gemm_kloop_n256(yb + (size_t)mt * 128 * 1024, 1024, WbT + (size_t)nt2 * 256 * 1024, 1024, acc, smem);
    stage_all_bf16(acc, smem);
#pragma unroll 1
    for (int hh = 0; hh < 2; ++hh) epi_pass16(smem, hh, mt * 128, (nt2 * 2 + hh) * 128, epiB);
    __syncthreads();
  }
#pragma unroll 1
  for (int nt = blockIdx.x; nt < 8; nt += gridDim.x) {
    f32x4 acc[4][4];
    zero_acc(acc);
    gemm_kloop(yb + (size_t)TP * 1024, 1024, WbT + (size_t)nt * 128 * 1024, 1024, 1024, acc, smem);
    gemm_epilogue(acc, smem, TP, nt * 128, epiB);
  }
}

__device__ void phase_out(const P& p, char* smem) {
  const bf16_t* merged = (const bf16_t*)(p.ws + OFF_ACT);
  const bf16_t* WoutT = (const bf16_t*)(p.ws + OFF_WOUTT);
  const float* mod = (const float*)(p.ws + OFF_MOD);
  bf16_t* x1 = (bf16_t*)(p.ws + OFF_XBC);
  auto epi = [&](int row, int col, const float (&v)[8]) {
    const float* xr = (row < TP ? p.in[0] + (size_t)row * 1024 : p.in[1] + (size_t)(row - TP) * 1024) + col;
    const float* gt = mod + (size_t)mrow(row) * 6144 + 2048 + col;
    float4 a = *(const float4*)xr, b = *(const float4*)(xr + 4);
    float4 g0 = *(const float4*)gt, g1 = *(const float4*)(gt + 4);
    float o[8] = {a.x + g0.x * v[0], a.y + g0.y * v[1], a.z + g0.z * v[2], a.w + g0.w * v[3],
                  b.x + g1.x * v[4], b.y + g1.y * v[5], b.z + g1.z * v[6], b.w + g1.w * v[7]};
    store8bf(x1 + (size_t)row * 1024 + col, o);
  };
#pragma unroll 1
  for (int tile = blockIdx.x; tile < 512; tile += gridDim.x) {
    const int mt = tile >> 2, nt2 = tile & 3;
    f32x4 acc[4][8];
    zero_acc8(acc);
    gemm_kloop_n256(merged + (size_t)mt * 128 * 1024, 1024, WoutT + (size_t)nt2 * 256 * 1024, 1024, acc, smem);
    stage_all_bf16(acc, smem);
#pragma unroll 1
    for (int hh = 0; hh < 2; ++hh) epi_pass16(smem, hh, mt * 128, (nt2 * 2 + hh) * 128, epi);
    __syncthreads();
  }
#pragma unroll 1
  for (int nt = blockIdx.x; nt < 8; nt += gridDim.x) {
    f32x4 acc[4][4];
    zero_acc(acc);
    gemm_kloop(merged + (size_t)TP * 1024, 1024, WoutT + (size_t)nt * 128 * 1024, 1024, 1024, acc, smem);
    gemm_epilogue(acc, smem, TP, nt * 128, epi);
  }
}

__device__ void phase_query(const P& p, char* smem) {
  const bf16_t* h2 = (const bf16_t*)(p.ws + OFF_ACT);
  const bf16_t* WqT = (const bf16_t*)(p.ws + OFF_WQT);
  const bf16_t* keysB = (const bf16_t*)(p.ws + OFF_KEYS);
  float* topk1 = (float*)(p.ws + OFF_Z);
  const int tid = threadIdx.x, lane = tid & 63, wid = tid >> 6, wr = wid >> 1, wc = wid & 1, fr = lane & 15, fq = lane >> 4;
  for (int tile = blockIdx.x; tile < 129 * 16; tile += gridDim.x) {
    int mt = tile >> 4, nt = tile & 15;
    f32x4 acc[4][4];
    zero_acc(acc);
    gemm_kloop(h2 + (size_t)mt * 128 * 1024, 1024, WqT + (size_t)nt * 128 * 1024, 1024, 1024, acc, smem);
    bf16_t* Qs = (bf16_t*)smem;
    bf16_t* Ks = (bf16_t*)(smem + 34816);
#pragma unroll
    for (int m = 0; m < 4; ++m)
#pragma unroll
      for (int n = 0; n < 4; ++n)
#pragma unroll
        for (int r = 0; r < 4; ++r)
          Qs[(wr * 64 + m * 16 + fq * 4 + r) * 136 + wc * 64 + n * 16 + fr] = f2bf(acc[m][n][r]);
    {
      const bf16_t* kp = keysB + (size_t)nt * 16384;
#pragma unroll
      for (int i = 0; i < 8; ++i) {
        int idx = tid + 256 * i;
        int row = idx >> 4, c8 = (idx & 15) * 8;
        *(uint4*)(Ks + row * 136 + c8) = *(const uint4*)(kp + row * 128 + c8);
      }
    }
    __syncthreads();
    zero_acc(acc);
#pragma unroll
    for (int ks = 0; ks < 4; ++ks) {
      bf16x8 a[4], b[4];
#pragma unroll
      for (int m = 0; m < 4; ++m) a[m] = *(const bf16x8*)(Qs + (wr * 64 + m * 16 + fr) * 136 + ks * 32 + fq * 8);
#pragma unroll
      for (int n = 0; n < 4; ++n) b[n] = *(const bf16x8*)(Ks + (wc * 64 + n * 16 + fr) * 136 + ks * 32 + fq * 8);
#pragma unroll
      for (int m = 0; m < 4; ++m)
#pragma unroll
        for (int n = 0; n < 4; ++n)
          acc[m][n] = __builtin_amdgcn_mfma_f32_16x16x32_bf16(a[m], b[n], acc[m][n], 0, 0, 0);
    }
    __syncthreads();
    float* Sc = (float*)smem;
#pragma unroll
    for (int m = 0; m < 4; ++m)
#pragma unroll
      for (int n = 0; n < 4; ++n)
#pragma unroll
        for (int r = 0; r < 4; ++r) {
          int col = wc * 64 + n * 16 + fr;
          unsigned bits = (__float_as_uint(acc[m][n][r]) & ~127u) | (unsigned)(127 - col);
          Sc[(wr * 64 + m * 16 + fq * 4 + r) * 136 + col] = __uint_as_float(bits);
        }
    __syncthreads();
    {
      const int sub = lane & 15, grp = lane >> 4;
#pragma unroll 1
      for (int pass = 0; pass < 8; ++pass) {
        int row = wid * 32 + pass * 4 + grp;
        float v[8];
#pragma unroll
        for (int i = 0; i < 8; ++i) v[i] = Sc[row * 136 + sub + 16 * i];
#define CEX(i, j) { float hi_ = fmaxf(v[i], v[j]), lo_ = fminf(v[i], v[j]); v[i] = hi_; v[j] = lo_; }
        CEX(0, 1) CEX(2, 3) CEX(4, 5) CEX(6, 7)
        CEX(0, 2) CEX(1, 3) CEX(4, 6) CEX(5, 7)
        CEX(1, 2) CEX(5, 6)
        CEX(0, 4) CEX(1, 5) CEX(2, 6) CEX(3, 7)
        CEX(2, 4) CEX(3, 5)
        CEX(1, 2) CEX(3, 4) CEX(5, 6)
#undef CEX
        float mine = 0.f;
#pragma unroll
        for (int r = 0; r < 16; ++r) {
          const float m = row16_max(v[0]);
          const bool pop = (v[0] == m);
#pragma unroll
          for (int i = 0; i < 7; ++i) v[i] = pop ? v[i + 1] : v[i];
          v[7] = pop ? -INFINITY : v[7];
          if (sub == r) mine = m;
        }
        topk1[((size_t)(mt * 128 + row) * 16 + nt) * 16 + sub] = mine;
      }
    }
    __syncthreads();
  }
}

typedef __attribute__((ext_vector_type(2))) float f32x2_t;
DI void fp8x4_to_f32(unsigned w, float (&o)[4]) {
  f32x2_t lo = __builtin_amdgcn_cvt_pk_f32_fp8((int)w, false);
  f32x2_t hi = __builtin_amdgcn_cvt_pk_f32_fp8((int)w, true);
  o[0] = lo.x; o[1] = lo.y; o[2] = hi.x; o[3] = hi.y;
}
template <int NHD, bool COOP>
DI void peer_token(const P& p, char* smem, const int t, const int hd0, const int ci, const int cj) {
  const int lane = threadIdx.x & 63, wid = threadIdx.x >> 6;
  int* e_lds = (int*)(smem + wid * 4096);
  float* g_lds = (float*)(e_lds + 128);
  float* a_lds = g_lds + 128;
  float* sd_lds = a_lds + 128;
  float* su_lds = sd_lds + 128;
  const bf16_t* h2 = (const bf16_t*)(p.ws + OFF_ACT);
  const float* topk1 = (const float*)(p.ws + OFF_Z);
  const unsigned char* Ed = (const unsigned char*)(p.ws + OFF_E8);
  const unsigned char* Eu = Ed + 16777216;
  const float* Esc = (const float*)(p.ws + OFF_E8 + 33554432);
  const bf16_t* x1 = (const bf16_t*)(p.ws + OFF_XBC);
  const float* mod = (const float*)(p.ws + OFF_MOD);
  const float* modf = (const float*)(p.ws + OFF_MODF);
  const float* gfin = p.in[36];
  const int sub = lane & 15, grp = lane >> 4;
    f32x2_t hq2[32];
#pragma unroll
    for (int i = 0; i < 4; ++i) {
      const bf16_t* hp = h2 + (size_t)t * 1024 + i * 256 + sub * 16;
      uint4 u0 = *(const uint4*)hp, u1 = *(const uint4*)(hp + 8);
      float f0[8], f1[8];
      unpack8(u0, f0); unpack8(u1, f1);
#pragma unroll
      for (int j = 0; j < 4; ++j) {
        hq2[i * 8 + j] = f32x2_t{f0[2 * j], f0[2 * j + 1]};
        hq2[i * 8 + 4 + j] = f32x2_t{f1[2 * j], f1[2 * j + 1]};
      }
    }
    float tkv0[NHD], tkv1[NHD];
#pragma unroll
    for (int q = 0; q < NHD; ++q) {
      const float* tk = topk1 + ((size_t)t * 16 + (hd0 + q) * 2) * 16;
      tkv0[q] = tk[ci >= 0 ? ci : 0]; tkv1[q] = tk[16 + cj];
    }
#pragma unroll
    for (int hq_ = 0; hq_ < NHD; ++hq_) {
      const int hd = hd0 + hq_;
      float v0 = tkv0[hq_], v1 = tkv1[hq_];
      unsigned b0 = __float_as_uint(v0), b1 = __float_as_uint(v1);
      int i0 = 127 - (int)(b0 & 127u), i1 = 127 - (int)(b1 & 127u);
      float cand = __uint_as_float(b0 & ~127u) + __uint_as_float(b1 & ~127u);
      int eidx = i0 * 128 + i1;
      float key = (ci >= 0) ? __uint_as_float((__float_as_uint(cand) & ~63u) | (unsigned)(63 - lane)) : -INFINITY;
      int rank = 0;
#pragma unroll
      for (int j = 0; j < 50; ++j) {
        float kj = __builtin_bit_cast(float, __builtin_amdgcn_readlane(__builtin_bit_cast(int, key), j));
        rank += (kj > key) ? 1 : 0;
      }
      const bool sel = (ci >= 0) && (rank < 16);
      float fv = __uint_as_float(__float_as_uint(key) & ~63u);
      float mx = __builtin_bit_cast(float, __builtin_amdgcn_readlane(__builtin_bit_cast(int, fv), 0));
      float ex = sel ? __expf(fv - mx) : 0.f;
      float sm = wave_sum_fast(ex);
      if (sel) {
        e_lds[(hd - hd0) * 16 + rank] = eidx; g_lds[(hd - hd0) * 16 + rank] = ex / sm;
        sd_lds[(hd - hd0) * 16 + rank] = Esc[eidx]; su_lds[(hd - hd0) * 16 + rank] = Esc[16384 + eidx];
      }
    }
    __builtin_amdgcn_fence(__ATOMIC_RELEASE, "workgroup");
    __builtin_amdgcn_wave_barrier();
#pragma unroll 2
    for (int it = 0; it < NHD * 4; ++it) {
      int slot = it * 4 + grp;
      int e = e_lds[slot];
      const uint4* row = (const uint4*)(Ed + (size_t)e * 1024 + sub * 16);
      uint4 wv[4];
#pragma unroll
      for (int i = 0; i < 4; ++i) wv[i] = row[i * 16];
      f32x2_t acc2 = {0.f, 0.f}, acc3 = {0.f, 0.f};
#pragma unroll
      for (int i = 0; i < 4; ++i) {
        const unsigned ww[4] = {wv[i].x, wv[i].y, wv[i].z, wv[i].w};
#pragma unroll
        for (int j = 0; j < 4; ++j) {
          const f32x2_t lo = __builtin_amdgcn_cvt_pk_f32_fp8((int)ww[j], false);
          const f32x2_t hi = __builtin_amdgcn_cvt_pk_f32_fp8((int)ww[j], true);
          acc2 = lo * hq2[i * 8 + j * 2] + acc2;
          acc3 = hi * hq2[i * 8 + j * 2 + 1] + acc3;
        }
      }
      float acc = (acc2.x + acc2.y) + (acc3.x + acc3.y);
      acc = row16_sum(acc);
      if (sub == 0) a_lds[slot] = acc;
    }
    __builtin_amdgcn_fence(__ATOMIC_RELEASE, "workgroup");
    __builtin_amdgcn_wave_barrier();
#pragma unroll
    for (int s2 = lane; s2 < NHD * 16; s2 += 64)
      a_lds[s2] = geluf(a_lds[s2] * sd_lds[s2]) * g_lds[s2] * su_lds[s2];
    __builtin_amdgcn_fence(__ATOMIC_RELEASE, "workgroup");
    __builtin_amdgcn_wave_barrier();
    f32x2_t o2[8];
#pragma unroll
    for (int i = 0; i < 8; ++i) o2[i] = f32x2_t{0.f, 0.f};
#pragma unroll 8
    for (int s = 0; s < NHD * 16; ++s) {
      int e = e_lds[s];
      const float a = a_lds[s];
      const f32x2_t a2 = {a, a};
      uint4 w = *(const uint4*)(Eu + (size_t)e * 1024 + lane * 16);
      const unsigned ww[4] = {w.x, w.y, w.z, w.w};
#pragma unroll
      for (int j = 0; j < 4; ++j) {
        o2[2 * j] = __builtin_amdgcn_cvt_pk_f32_fp8((int)ww[j], false) * a2 + o2[2 * j];
        o2[2 * j + 1] = __builtin_amdgcn_cvt_pk_f32_fp8((int)ww[j], true) * a2 + o2[2 * j + 1];
      }
    }
    float o[16];
#pragma unroll
    for (int i = 0; i < 8; ++i) { o[2 * i] = o2[i].x; o[2 * i + 1] = o2[i].y; }
    if (COOP) {
      float* part = (float*)(smem + 16384);
#pragma unroll
      for (int i = 0; i < 16; ++i) part[wid * 1024 + lane * 16 + i] = o[i];
      __syncthreads();
      if (wid != 0) return;
#pragma unroll
      for (int i = 0; i < 16; ++i) o[i] = part[lane * 16 + i] + part[1024 + lane * 16 + i] + part[2048 + lane * 16 + i] + part[3072 + lane * 16 + i];
    }
    const int mr = mrow(t);
    const int c0 = lane * 16;
    float x2[16];
    float ss = 0.f;
    {
      const bf16_t* xr = x1 + (size_t)t * 1024 + c0;
      const float* gt = mod + (size_t)mr * 6144 + 5120 + c0;
      uint4 xa = *(const uint4*)xr, xb2 = *(const uint4*)(xr + 8);
      float xf[16];
      {
        float f0[8], f1[8];
        unpack8(xa, f0); unpack8(xb2, f1);
#pragma unroll
        for (int i = 0; i < 8; ++i) { xf[i] = f0[i]; xf[8 + i] = f1[i]; }
      }
#pragma unroll
      for (int q = 0; q < 4; ++q) {
        float4 g = *(const float4*)(gt + 4 * q);
        x2[4 * q + 0] = xf[4 * q + 0] + g.x * o[4 * q + 0]; x2[4 * q + 1] = xf[4 * q + 1] + g.y * o[4 * q + 1];
        x2[4 * q + 2] = xf[4 * q + 2] + g.z * o[4 * q + 2]; x2[4 * q + 3] = xf[4 * q + 3] + g.w * o[4 * q + 3];
      }
    }
#pragma unroll
    for (int i = 0; i < 16; ++i) ss += x2[i] * x2[i];
    ss = wave_sum_fast(ss);
    float rs = rsqrtf(ss * (1.f / 1024.f) + 1e-6f);
    {
      const float* sh = modf + (size_t)mr * 2048 + c0;
      const float* sc = sh + 1024;
      float* d = p.out + O_Y + (size_t)t * 1024 + c0;
#pragma unroll
      for (int q = 0; q < 4; ++q) {
        float4 shv = *(const float4*)(sh + 4 * q), scv = *(const float4*)(sc + 4 * q), gf = *(const float4*)(gfin + c0 + 4 * q);
        float4 y;
        y.x = x2[4 * q + 0] * rs * gf.x * (1.f + scv.x) + shv.x;
        y.y = x2[4 * q + 1] * rs * gf.y * (1.f + scv.y) + shv.y;
        y.z = x2[4 * q + 2] * rs * gf.z * (1.f + scv.z) + shv.z;
        y.w = x2[4 * q + 3] * rs * gf.w * (1.f + scv.w) + shv.w;
        *(float4*)(d + 4 * q) = y;
      }
    }
    __builtin_amdgcn_fence(__ATOMIC_RELEASE, "workgroup");
    __builtin_amdgcn_wave_barrier();
}

__device__ void phase_peer(const P& p, char* smem) {
  const int lane = threadIdx.x & 63, wid = threadIdx.x >> 6;
  int ci = -1, cj = 0;
  {
    int c = lane;
#pragma unroll
    for (int i = 0; i < 16; ++i) {
      int cnt = 16 / (i + 1);
      if (ci < 0) { if (c < cnt) { ci = i; cj = c; } else c -= cnt; }
    }
  }
#pragma unroll 1
  for (int t = blockIdx.x * 4 + wid; t < TP; t += gridDim.x * 4) peer_token<8, false>(p, smem, t, 0, ci, cj);
#pragma unroll 1
  for (int b = blockIdx.x; b < TT - TP; b += gridDim.x) {
    __syncthreads();
    peer_token<2, true>(p, smem, TP + b, wid * 2, ci, cj);
    __syncthreads();
  }
}

template <int PH>
DI void run_phase(const P& p, char* smem) {
  if constexpr (PH == 0) phase0(p, smem);
  else if constexpr (PH == 1) phase_mod(p, smem);
  else if constexpr (PH == 2) phase_norm(p, 0);
  else if constexpr (PH == 3) phase_inproj(p, smem);
  else if constexpr (PH == 4) phase_mixers(p, smem);
  else if constexpr (PH == 5) phase_glu(p, smem);
  else if constexpr (PH == 6) phase_merge(p, smem);
  else if constexpr (PH == 7) phase_out(p, smem);
  else if constexpr (PH == 8) phase_norm(p, 1);
  else if constexpr (PH == 9) phase_query(p, smem);
  else phase_peer(p, smem);
}

#define XB_TMO      128
#define XB_XCNT(j)  (256  + 64 * (j))
#define XB_XSUB(j)  (1280 + 64 * (j))
#define XB_XGEN(j)  (2304 + 64 * (j))
#define XB_TOP      3328
#define XB_TOPGEN   3392
#define XCD_BAR_WORDS 3456
#define XB_SPIN_CAP (1u << 20)
#define LAS __attribute__((address_space(3)))

__device__ __forceinline__ unsigned xb_ld(unsigned* p)              { return __hip_atomic_load(p, __ATOMIC_RELAXED, __HIP_MEMORY_SCOPE_AGENT); }
__device__ __forceinline__ unsigned xb_add(unsigned* p, unsigned v) { return __hip_atomic_fetch_add(p, v, __ATOMIC_RELAXED, __HIP_MEMORY_SCOPE_AGENT); }
__device__ __forceinline__ unsigned xb_xcc_id() { return (unsigned)__builtin_amdgcn_s_getreg((3 << 11) | 20) & 0xFu; }
#define XB_SPIN(cond, bar) do { unsigned _sp = 0; while (cond) { __builtin_amdgcn_s_sleep(1); \
    if ((++_sp & 255u) == 0u) { if (xb_ld(&(bar)[XB_TMO])) break; if (_sp > XB_SPIN_CAP) { atomicAdd(&(bar)[XB_TMO], 1u); break; } } } } while (0)

struct XcdBarrier {
    unsigned* bar; unsigned x;
    volatile LAS unsigned* st;
};

__device__ __forceinline__ XcdBarrier xcd_barrier_post(unsigned* bar, volatile LAS unsigned* st) {
    XcdBarrier b; b.bar = bar; b.x = xb_xcc_id(); b.st = st;
    if (threadIdx.x == 0) (void)xb_add(&bar[XB_XCNT(b.x)], 1u);
    return b;
}
__device__ __forceinline__ void xcd_barrier_complete(unsigned* bar, unsigned x, unsigned& nloc, unsigned& nx) {
    const unsigned G = gridDim.x * gridDim.y * gridDim.z;
    unsigned sum, cnt, mine, sp = 0u;
    for (;;) {
        sum = 0u; cnt = 0u; mine = 0u;
#pragma unroll
        for (unsigned j = 0; j < 16; ++j) { const unsigned c = xb_ld(&bar[XB_XCNT(j)]); sum += c; cnt += (c > 0u) ? 1u : 0u; mine = (j == x) ? c : mine; }
        if (sum == G) break;
        __builtin_amdgcn_s_sleep(1);
        if ((++sp & 255u) == 0u) { if (xb_ld(&bar[XB_TMO])) break; if (sp > XB_SPIN_CAP) { atomicAdd(&bar[XB_TMO], 1u); break; } }
    }
    nloc = mine > 0u ? mine : 1u; nx = cnt > 0u ? cnt : 1u;
}

__device__ __forceinline__ void xcd_barrier(const XcdBarrier& b) {
    asm volatile("s_waitcnt vmcnt(0)" ::: "memory");
    __syncthreads();
    if (threadIdx.x == 0) {
        unsigned* bar = b.bar;
        __builtin_amdgcn_s_waitcnt(0);
        unsigned nloc = b.st[0], nx = b.st[1];
        if (nloc == 0u) { xcd_barrier_complete(bar, b.x, nloc, nx); b.st[0] = nloc; b.st[1] = nx; }
        const unsigned old = xb_add(&bar[XB_XSUB(b.x)], 1u);
        const unsigned gen = old / nloc;
        if (old + 1u == (gen + 1u) * nloc) {
            __builtin_amdgcn_fence(__ATOMIC_RELEASE, "agent");
            asm volatile("s_waitcnt vmcnt(0)" ::: "memory");
            const unsigned og = xb_add(&bar[XB_TOP], 1u);
            const unsigned tg = og / nx;
            if (og + 1u == (tg + 1u) * nx) xb_add(&bar[XB_TOPGEN], 1u);
            else XB_SPIN(xb_ld(&bar[XB_TOPGEN]) == tg, bar);
            __builtin_amdgcn_fence(__ATOMIC_ACQUIRE, "agent");
            xb_add(&bar[XB_XGEN(b.x)], 1u);
            asm volatile("s_waitcnt vmcnt(0)" ::: "memory");
        } else {
            XB_SPIN(xb_ld(&bar[XB_XGEN(b.x)]) == gen, bar);
            __builtin_amdgcn_fence(__ATOMIC_ACQUIRE, "agent");
            asm volatile("s_waitcnt vmcnt(0)" ::: "memory");
        }
    }
    __syncthreads();
}


__global__ void __launch_bounds__(256, 2) mega(P p) {
  extern __shared__ __attribute__((aligned(16))) char smem[];
  cg::grid_group grid = cg::this_grid();
  if (threadIdx.x == 0) *(uint4*)(smem + 80384) = make_uint4(0u, 0u, 0u, 0u);
  __syncthreads();
  XcdBarrier xb = xcd_barrier_post((unsigned*)(p.ws + OFF_BAR), (volatile LAS unsigned*)(smem + 80384));
  if (p.ws == nullptr) grid.sync();
  run_phase<0>(p, smem);  xcd_barrier(xb);
  run_phase<1>(p, smem);  xcd_barrier(xb);
  run_phase<2>(p, smem);  xcd_barrier(xb);
  run_phase<3>(p, smem);  xcd_barrier(xb);
  phase_convfix(p);       xcd_barrier(xb);
  run_phase<4>(p, smem);  xcd_barrier(xb);
  run_phase<5>(p, smem);  xcd_barrier(xb);
  run_phase<6>(p, smem);  xcd_barrier(xb);
  run_phase<7>(p, smem);  xcd_barrier(xb);
  run_phase<8>(p, smem);  xcd_barrier(xb);
  run_phase<9>(p, smem);  xcd_barrier(xb);
  run_phase<10>(p, smem);
}

extern "C" void kernel_launch(void* const* d_in, const int* in_sizes, int n_in, void* d_out, int out_size,
                              void* d_ws, size_t ws_size, hipStream_t stream) {
  static int grid_blocks = 0;
  if (!grid_blocks) {
    int dev = 0, cus = 0, per_cu = 0;
    (void)hipGetDevice(&dev);
    (void)hipDeviceGetAttribute(&cus, hipDeviceAttributeMultiprocessorCount, dev);
    (void)hipFuncSetAttribute((const void*)mega, hipFuncAttributeMaxDynamicSharedMemorySize, SMEM_BYTES);
    (void)hipOccupancyMaxActiveBlocksPerMultiprocessor(&per_cu, mega, 256, SMEM_BYTES);
    if (per_cu < 1) per_cu = 1;
    if (per_cu > 2) per_cu = 2;
    grid_blocks = cus * per_cu;
  }
  if (ws_size < WS_NEED) { fprintf(stderr, "workspace too small: %zu < %zu\n", ws_size, (size_t)WS_NEED); return; }
  P p{};
  for (int i = 0; i < 39; ++i) p.in[i] = (const float*)d_in[i];
  p.out = (float*)d_out;
  p.ws = (char*)d_ws;
  (void)hipMemsetAsync((char*)d_ws + OFF_BAR, 0, 16384, stream);
  void* args[] = {&p};
  hipError_t e = hipLaunchCooperativeKernel((void*)mega, dim3(grid_blocks), dim3(256), args, SMEM_BYTES, stream);
  if (e != hipSuccess) fprintf(stderr, "cooperative launch failed: %s (grid %d)\n", hipGetErrorString(e), grid_blocks);
}
```

```cpp
#include <hip/hip_runtime.h>
#include <hip/hip_cooperative_groups.h>
#include <cstdio>
#include <cstdint>
namespace cg = cooperative_groups;

typedef unsigned short bf16_t;
using bf16x8 = __attribute__((ext_vector_type(8))) short;
using bf16x2v = __attribute__((ext_vector_type(2))) __bf16;
using f32x4 = __attribute__((ext_vector_type(4))) float;
using f32x16 = __attribute__((ext_vector_type(16))) float;
#define DI __device__ __forceinline__

struct P { const float* in[39]; float* out; char* ws; };

constexpr int TT = 16512, TP = 16384;
constexpr size_t OFF_WINT = 0;
constexpr size_t OFF_WGLUT = OFF_WINT + 12058624;
constexpr size_t OFF_WAT = OFF_WGLUT + 524288;
constexpr size_t OFF_WBT = OFF_WAT + 1048576;
constexpr size_t OFF_WOUTT = OFF_WBT + 2097152;
constexpr size_t OFF_WQT = OFF_WOUTT + 2097152;
constexpr size_t OFF_KEYS = OFF_WQT + 4194304;
constexpr size_t OFF_SCB = OFF_KEYS + 524288;
constexpr size_t OFF_MOD = OFF_SCB + 524288;
constexpr size_t OFF_MODF = OFF_MOD + 3342336;
constexpr size_t OFF_DTB = OFF_MODF + 1114112;
constexpr size_t OFF_ACT = OFF_DTB + 1056768;
constexpr size_t OFF_U = OFF_ACT + 33816576;
constexpr size_t OFF_Z = OFF_U + 16908288;
constexpr size_t OFF_XBC = OFF_Z + 33816576;
constexpr size_t OFF_GATES = OFF_XBC + 67633152;
constexpr size_t OFF_YS5 = OFF_GATES + 67633152;
constexpr size_t OFF_YSSD = OFF_YS5 + 16908288;
constexpr size_t OFF_BAR = OFF_YSSD + 33816576;
constexpr size_t OFF_TAILS = OFF_BAR + 16384;
constexpr size_t OFF_E8 = OFF_TAILS + 1572864;
constexpr size_t WS_NEED = OFF_E8 + 33554432 + 131072;

constexpr size_t O_Y = 0;
constexpr size_t O_S5RE_P = 16908288;
constexpr size_t O_S5IM_P = O_S5RE_P + 16384;
constexpr size_t O_SSM_P = O_S5IM_P + 16384;
constexpr size_t O_CONV_P = O_SSM_P + 1048576;
constexpr size_t O_S5RE_S = O_CONV_P + 49152;
constexpr size_t O_S5IM_S = O_S5RE_S + 262144;
constexpr size_t O_SSM_S = O_S5IM_S + 262144;
constexpr size_t O_CONV_S = O_SSM_S + 16777216;

constexpr int SMEM_BYTES = 80400;

DI float bf2f(bf16_t b) { return __uint_as_float(((unsigned)b) << 16); }
DI float bflo(unsigned u) { return __uint_as_float(u << 16); }
DI float bfhi(unsigned u) { return __uint_as_float(u & 0xffff0000u); }
typedef __attribute__((ext_vector_type(2))) float f2v_t;
typedef __attribute__((ext_vector_type(2))) __bf16 b2v_t;
DI unsigned cvtpk(float lo, float hi) { f2v_t v = {lo, hi}; b2v_t r = __builtin_convertvector(v, b2v_t); return __builtin_bit_cast(unsigned, r); }
typedef __attribute__((ext_vector_type(4))) unsigned u32x4_t;
DI bf16x8 mk8(unsigned a, unsigned b, unsigned c, unsigned d) { u32x4_t v = {a, b, c, d}; return __builtin_bit_cast(bf16x8, v); }
DI bf16_t f2bf(float f) { return (bf16_t)(cvtpk(f, 0.f) & 0xffffu); }
DI float siluf(float x) { return x * __builtin_amdgcn_rcpf(1.f + __expf(-x)); }
DI float sigmf(float x) { return __builtin_amdgcn_rcpf(1.f + __expf(-x)); }
DI float erf_as(float x) {
  const float ax = fabsf(x);
  const float t = __builtin_amdgcn_rcpf(1.f + 0.3275911f * ax);
  const float poly = t * (0.254829592f + t * (-0.284496736f + t * (1.421413741f + t * (-1.453152027f + t * 1.061405429f))));
  const float r = 1.f - poly * __expf(-ax * ax);
  return copysignf(r, x);
}
DI float geluf(float x) { return 0.5f * x * (1.f + erf_as(x * 0.70710678118654752f)); }
DI float dot2(unsigned a, unsigned b, float acc) {
  return __builtin_amdgcn_fdot2_f32_bf16(__builtin_bit_cast(bf16x2v, a), __builtin_bit_cast(bf16x2v, b), acc, false);
}
DI float wave_sum(float v) {
#pragma unroll
  for (int o = 32; o; o >>= 1) v += __shfl_xor(v, o);
  return v;
}
DI float wave_max(float v) {
#pragma unroll
  for (int o = 32; o; o >>= 1) v = fmaxf(v, __shfl_xor(v, o));
  return v;
}
template <int CTRL> DI float dppf(float x) {
  return __builtin_bit_cast(float, __builtin_amdgcn_mov_dpp(__builtin_bit_cast(int, x), CTRL, 0xf, 0xf, true));
}
DI float row16_max(float m) {
  m = fmaxf(m, dppf<0xB1>(m)); m = fmaxf(m, dppf<0x4E>(m)); m = fmaxf(m, dppf<0x141>(m)); m = fmaxf(m, dppf<0x128>(m));
  return m;
}
DI float row16_sum(float s) {
  s += dppf<0xB1>(s); s += dppf<0x4E>(s); s += dppf<0x141>(s); s += dppf<0x128>(s);
  return s;
}
DI float xrow16_sum(float x) {
  auto a = __builtin_amdgcn_permlane16_swap(__float_as_uint(x), __float_as_uint(x), false, false);
  x = __uint_as_float(a[0]) + __uint_as_float(a[1]);
  auto b = __builtin_amdgcn_permlane32_swap(__float_as_uint(x), __float_as_uint(x), false, false);
  return __uint_as_float(b[0]) + __uint_as_float(b[1]);
}
DI float wave_sum_fast(float s) { return xrow16_sum(row16_sum(s)); }
DI float wave_incl_scan(float v) {
  v += __builtin_bit_cast(float, __builtin_amdgcn_update_dpp(0, __builtin_bit_cast(int, v), 0x111, 0xf, 0xf, true));
  v += __builtin_bit_cast(float, __builtin_amdgcn_update_dpp(0, __builtin_bit_cast(int, v), 0x112, 0xf, 0xf, true));
  v += __builtin_bit_cast(float, __builtin_amdgcn_update_dpp(0, __builtin_bit_cast(int, v), 0x114, 0xf, 0xf, true));
  v += __builtin_bit_cast(float, __builtin_amdgcn_update_dpp(0, __builtin_bit_cast(int, v), 0x118, 0xf, 0xf, true));
  v += __builtin_bit_cast(float, __builtin_amdgcn_update_dpp(0, __builtin_bit_cast(int, v), 0x142, 0xa, 0xf, false));
  v += __builtin_bit_cast(float, __builtin_amdgcn_update_dpp(0, __builtin_bit_cast(int, v), 0x143, 0xc, 0xf, false));
  return v;
}
DI int mrow(int t) { return t < TP ? (t >> 11) : (8 + t - TP); }
DI void store8bf(bf16_t* dst, const float (&v)[8]) {
  uint4 o; o.x = cvtpk(v[0], v[1]); o.y = cvtpk(v[2], v[3]); o.z = cvtpk(v[4], v[5]); o.w = cvtpk(v[6], v[7]);
  *(uint4*)dst = o;
}
DI void unpack8(const uint4& u, float (&v)[8]) {
  v[0] = bflo(u.x); v[1] = bfhi(u.x); v[2] = bflo(u.y); v[3] = bfhi(u.y);
  v[4] = bflo(u.z); v[5] = bfhi(u.z); v[6] = bflo(u.w); v[7] = bfhi(u.w);
}

DI void tconv_tile(const float* __restrict__ src, int ldsrc, int srccol0, int nvalid, int k0,
                   bf16_t* __restrict__ dst, int lddst, int dstrow0, char* smem) {
  float* tile = (float*)smem;
  const int tid = threadIdx.x;
  const int nn = tid & 63, kb = tid >> 6;
#pragma unroll
  for (int i = 0; i < 16; ++i) {
    int kk = kb + 4 * i;
    float v = (nn < nvalid) ? src[(size_t)(k0 + kk) * ldsrc + srccol0 + nn] : 0.f;
    tile[kk * 65 + nn] = v;
  }
  __syncthreads();
  const int n = tid >> 2, kq = (tid & 3) * 16;
  unsigned o[8];
#pragma unroll
  for (int i = 0; i < 8; ++i) o[i] = cvtpk(tile[(kq + 2 * i) * 65 + n], tile[(kq + 2 * i + 1) * 65 + n]);
  const int nrow = dstrow0 + n, kk = k0 + kq;
  uint4* d = (uint4*)(dst + ((size_t)((nrow >> 7) * (lddst >> 5) + (kk >> 5)) * 128 + (nrow & 127)) * 32 + (kk & 31));
  d[0] = make_uint4(o[0], o[1], o[2], o[3]);
  d[1] = make_uint4(o[4], o[5], o[6], o[7]);
  __syncthreads();
}

constexpr int LDT = 72;
constexpr int TILE_ELEMS = 128 * LDT;

#define GLDS16(g, l) __builtin_amdgcn_global_load_lds((const unsigned*)(g), (unsigned*)(l), 16, 0, 0)
DI void gemm_kloop(const bf16_t* __restrict__ A, int lda, const bf16_t* __restrict__ B, int ldb, int K,
                   f32x4 (&acc)[4][4], char* smem) {
  const int tid = threadIdx.x, lane = tid & 63, wid = tid >> 6, wr = wid >> 1, wc = wid & 1, fr = lane & 15, fq = lane >> 4;
  const int r0 = tid >> 2;
  const int fsw = (0x78 >> (2 * ((r0 >> 2) & 3))) & 3;
  const int csrc = ((tid & 3) ^ fsw) * 8;
  const bf16_t* Ap0 = A + (size_t)r0 * lda + csrc;
  const bf16_t* Ap1 = A + (size_t)(r0 + 64) * lda + csrc;
  const bf16_t* Bp0 = B + r0 * 32 + csrc;
  const bf16_t* Bp1 = Bp0 + 2048;
  char* lw = smem + tid * 16;
  const int posl = (fq ^ ((0x78 >> (2 * ((fr >> 2) & 3))) & 3)) * 16;
  const char* ardA = smem + (wr * 64 + fr) * 64 + posl;
  const char* ardB = smem + 8192 + (wc * 64 + fr) * 64 + posl;
  const int nk = K >> 5;
  auto issue = [&](int kt) __attribute__((always_inline)) {
    char* base = lw + (kt & 3) * 16384;
    GLDS16(Ap0 + kt * 32, base);
    GLDS16(Ap1 + kt * 32, base + 4096);
    GLDS16(Bp0 + kt * 4096, base + 8192);
    GLDS16(Bp1 + kt * 4096, base + 12288);
  };
  issue(0); issue(1); issue(2);
#pragma unroll 1
  for (int kt = 0; kt < nk; ++kt) {
    if (kt + 2 < nk) asm volatile("s_waitcnt vmcnt(8)" ::: "memory");
    else if (kt + 1 < nk) asm volatile("s_waitcnt vmcnt(4)" ::: "memory");
    else asm volatile("s_waitcnt vmcnt(0)" ::: "memory");
    __builtin_amdgcn_s_barrier();
    if (kt + 3 < nk) issue(kt + 3);
    const char* pa = ardA + (kt & 3) * 16384;
    const char* pb = ardB + (kt & 3) * 16384;
    bf16x8 a[4], b[4];
#pragma unroll
    for (int m = 0; m < 4; ++m) a[m] = *(const bf16x8*)(pa + m * 1024);
#pragma unroll
    for (int n = 0; n < 4; ++n) b[n] = *(const bf16x8*)(pb + n * 1024);
#pragma unroll
    for (int m = 0; m < 4; ++m)
#pragma unroll
      for (int n = 0; n < 4; ++n)
        acc[m][n] = __builtin_amdgcn_mfma_f32_16x16x32_bf16(a[m], b[n], acc[m][n], 0, 0, 0);
  }
  __syncthreads();
}

DI void gemm_kloop_n256(const bf16_t* __restrict__ A, int lda, const bf16_t* __restrict__ B, int K,
                        f32x4 (&acc)[4][8], char* smem) {
  const int tid = threadIdx.x, lane = tid & 63, wid = tid >> 6, wr = wid >> 1, wc = wid & 1, fr = lane & 15, fq = lane >> 4;
  const int r0 = tid >> 2;
  const int fsw = (0x78 >> (2 * ((r0 >> 2) & 3))) & 3;
  const int csrc = ((tid & 3) ^ fsw) * 8;
  const bf16_t* Ap0 = A + (size_t)r0 * lda + csrc;
  const bf16_t* Ap1 = A + (size_t)(r0 + 64) * lda + csrc;
  const bf16_t* Bp0 = B + r0 * 32 + csrc;
  const bf16_t* Bp2 = Bp0 + (size_t)128 * K;
  char* lw = smem + tid * 16;
  const int posl = (fq ^ ((0x78 >> (2 * ((fr >> 2) & 3))) & 3)) * 16;
  const char* ardA = smem + (wr * 64 + fr) * 64 + posl;
  const char* ardB = smem + 8192 + (wc * 128 + fr) * 64 + posl;
  const int nk = K >> 5;
  auto issue = [&](int kt, int stg) __attribute__((always_inline)) {
    char* base = lw + stg * 24576;
    GLDS16(Ap0 + kt * 32, base);
    GLDS16(Ap1 + kt * 32, base + 4096);
    GLDS16(Bp0 + kt * 4096, base + 8192);
    GLDS16(Bp0 + kt * 4096 + 2048, base + 12288);
    GLDS16(Bp2 + kt * 4096, base + 16384);
    GLDS16(Bp2 + kt * 4096 + 2048, base + 20480);
  };
  issue(0, 0); issue(1, 1);
  int stg = 0;
#pragma unroll 1
  for (int kt = 0; kt < nk; ++kt) {
    if (kt + 1 < nk) asm volatile("s_waitcnt vmcnt(6)" ::: "memory");
    else asm volatile("s_waitcnt vmcnt(0)" ::: "memory");
    __builtin_amdgcn_s_barrier();
    const int stg2 = (stg == 0) ? 2 : stg - 1;
    if (kt + 2 < nk) issue(kt + 2, stg2);
    const char* pa = ardA + stg * 24576;
    const char* pb = ardB + stg * 24576;
    bf16x8 a[4], b[8];
#pragma unroll
    for (int m = 0; m < 4; ++m) a[m] = *(const bf16x8*)(pa + m * 1024);
#pragma unroll
    for (int n = 0; n < 8; ++n) b[n] = *(const bf16x8*)(pb + n * 1024);
    __builtin_amdgcn_s_setprio(1);
#pragma unroll
    for (int m = 0; m < 4; ++m)
#pragma unroll
      for (int n = 0; n < 8; ++n)
        acc[m][n] = __builtin_amdgcn_mfma_f32_16x16x32_bf16(a[m], b[n], acc[m][n], 0, 0, 0);
    __builtin_amdgcn_s_setprio(0);
    stg = (stg == 2) ? 0 : stg + 1;
  }
  __syncthreads();
}
DI void zero_acc8(f32x4 (&acc)[4][8]) {
#pragma unroll
  for (int m = 0; m < 4; ++m)
#pragma unroll
    for (int n = 0; n < 8; ++n) acc[m][n] = f32x4{0.f, 0.f, 0.f, 0.f};
}
constexpr int CS16 = 264;
DI void stage_all_bf16(f32x4 (&acc)[4][8], char* smem) {
  const int tid = threadIdx.x, lane = tid & 63, wid = tid >> 6, wr = wid >> 1, wc = wid & 1, fr = lane & 15, fq = lane >> 4;
  bf16_t* Cs = (bf16_t*)smem;
#pragma unroll
  for (int m = 0; m < 4; ++m)
#pragma unroll
    for (int n = 0; n < 8; ++n)
#pragma unroll
      for (int r = 0; r < 4; ++r)
        Cs[(wr * 64 + m * 16 + fq * 4 + r) * CS16 + wc * 128 + n * 16 + fr] = f2bf(acc[m][n][r]);
  __syncthreads();
}
DI void cs16_load8(const bf16_t* Cs, int row, int col, float (&v)[8]) {
  uint4 u = *(const uint4*)(Cs + row * CS16 + col);
  unpack8(u, v);
}
template <class Epi>
DI void epi_pass16(char* smem, int hh, int row0, int col0, Epi epi) {
  const int tid = threadIdx.x;
  const bf16_t* Cs = (const bf16_t*)smem;
#pragma unroll
  for (int i = 0; i < 8; ++i) {
    int idx = tid + 256 * i;
    int row = idx >> 4, c8 = (idx & 15) * 8;
    float v[8];
    cs16_load8(Cs, row, hh * 128 + c8, v);
    epi(row0 + row, col0 + c8, v);
  }
}
DI void zero_acc(f32x4 (&acc)[4][4]) {
#pragma unroll
  for (int m = 0; m < 4; ++m)
#pragma unroll
    for (int n = 0; n < 4; ++n) acc[m][n] = f32x4{0.f, 0.f, 0.f, 0.f};
}

template <class Epi>
DI void gemm_epilogue(f32x4 (&acc)[4][4], char* smem, int row0, int col0, Epi epi) {
  const int tid = threadIdx.x, lane = tid & 63, wid = tid >> 6, wr = wid >> 1, wc = wid & 1, fr = lane & 15, fq = lane >> 4;
  float* Cs = (float*)smem;
#pragma unroll
  for (int m = 0; m < 4; ++m)
#pragma unroll
    for (int n = 0; n < 4; ++n)
#pragma unroll
      for (int r = 0; r < 4; ++r)
        Cs[(wr * 64 + m * 16 + fq * 4 + r) * 132 + wc * 64 + n * 16 + fr] = acc[m][n][r];
  __syncthreads();
#pragma unroll
  for (int i = 0; i < 8; ++i) {
    int idx = tid + 256 * i;
    int row = idx >> 4, c8 = (idx & 15) * 8;
    float4 x0 = *(const float4*)(Cs + row * 132 + c8);
    float4 x1 = *(const float4*)(Cs + row * 132 + c8 + 4);
    float v[8] = {x0.x, x0.y, x0.z, x0.w, x1.x, x1.y, x1.z, x1.w};
    epi(row0 + row, col0 + c8, v);
  }
  __syncthreads();
}

__device__ void phase0(const P& p, char* smem) {
  bf16_t* WinT = (bf16_t*)(p.ws + OFF_WINT);
  bf16_t* WadaT = (bf16_t*)(p.ws + OFF_YS5);
  bf16_t* WgluT = (bf16_t*)(p.ws + OFF_WGLUT);
  bf16_t* WaT = (bf16_t*)(p.ws + OFF_WAT);
  bf16_t* WbT = (bf16_t*)(p.ws + OFF_WBT);
  bf16_t* WoutT = (bf16_t*)(p.ws + OFF_WOUTT);
  bf16_t* WqT = (bf16_t*)(p.ws + OFF_WQT);
  bf16_t* keysB = (bf16_t*)(p.ws + OFF_KEYS);
  bf16_t* scb = (bf16_t*)(p.ws + OFF_SCB);
  const int tid = threadIdx.x;
  const int NTASK = 2048 + 128 + 128 + 256;
  for (int task = blockIdx.x; task < NTASK; task += gridDim.x) {
    int t = task;
    if (t < 1536) { int nt = t >> 4, kt = t & 15; tconv_tile(p.in[8], 6144, nt * 64, 64, kt * 64, WadaT, 1024, nt * 64, smem); continue; }
    t -= 1536;
    if (t < 512) { int nt = t >> 4, kt = t & 15; tconv_tile(p.in[37], 2048, nt * 64, 64, kt * 64, WadaT, 1024, 6144 + nt * 64, smem); continue; }
    t -= 512;
    if (t < 128) {
      size_t e = (size_t)t * 2048 + tid * 8;
      const float* s = p.in[33] + e;
      float4 a = *(const float4*)s, b = *(const float4*)(s + 4);
      float v[8] = {a.x, a.y, a.z, a.w, b.x, b.y, b.z, b.w};
      store8bf(keysB + e, v);
      continue;
    }
    t -= 128;
    if (t < 128) {
      int e = t * 2048 + tid * 8;
      int r = e >> 10, c = e & 1023;
      float v[8];
      if (r < 136) {
        const float* s = (r < 8) ? (p.in[6] + r * 1024 + c) : (p.in[7] + (r - 8) * 1024 + c);
        float4 a = *(const float4*)s, b = *(const float4*)(s + 4);
        float w[8] = {a.x, a.y, a.z, a.w, b.x, b.y, b.z, b.w};
#pragma unroll
        for (int i = 0; i < 8; ++i) v[i] = siluf(w[i]);
      } else {
#pragma unroll
        for (int i = 0; i < 8; ++i) v[i] = 0.f;
      }
      store8bf(scb + e, v);
      continue;
    }
    t -= 128;
    {
      int e = t * 2048 + tid * 8;
      int b = e >> 12, r = (e >> 11) & 1, ch = e & 2047;
      const float* s = p.in[5] + ((size_t)(b * 3 + r + 1)) * 2048 + ch;
      float* d = p.out + O_CONV_S + ((size_t)(b * 3 + r)) * 2048 + ch;
      *(float4*)d = *(const float4*)s;
      *(float4*)(d + 4) = *(const float4*)(s + 4);
    }
  }
}

__device__ void phase_mod(const P& p, char* smem) {
  const bf16_t* scb = (const bf16_t*)(p.ws + OFF_SCB);
  const bf16_t* WadaT = (const bf16_t*)(p.ws + OFF_YS5);
  float* mod = (float*)(p.ws + OFF_MOD);
  float* modf = (float*)(p.ws + OFF_MODF);
  const float* b_ada = p.in[9];
  const float* b_adaf = p.in[38];
  {
    bf16_t* WinT = (bf16_t*)(p.ws + OFF_WINT);
    const int G = gridDim.x;
    const int nconv = (G > 128) ? (G - 128) : G;
    const int first = (G > 128) ? ((int)blockIdx.x - 128) : (int)blockIdx.x;
    if (first >= 0) {
      for (int t = first; t < 1472; t += nconv) {
        int nt = t >> 4, kt = t & 15, n0 = nt * 64, src, nv;
        if (n0 < 3584) { src = n0; nv = 64; }
        else if (n0 < 5632) { src = n0 + 16; nv = 64; }
        else if (n0 == 5632) { src = 3584; nv = 16; }
        else { src = 0; nv = 0; }
        tconv_tile(p.in[12], 5648, src, nv, kt * 64, WinT, 1024, n0, smem);
      }
    }
  }
  for (int tile = blockIdx.x; tile < 128; tile += gridDim.x) {
    int mt = tile & 1, nt = tile >> 1;
    f32x4 acc[4][4];
    zero_acc(acc);
    gemm_kloop(scb + (size_t)mt * 128 * 1024, 1024, WadaT + (size_t)nt * 128 * 1024, 1024, 1024, acc, smem);
    gemm_epilogue(acc, smem, mt * 128, nt * 128, [&](int row, int col, const float (&v)[8]) {
      if (row >= 136) return;
      if (col < 6144) {
        float* d = mod + (size_t)row * 6144 + col;
#pragma unroll
        for (int i = 0; i < 8; ++i) d[i] = v[i] + b_ada[col + i];
      } else {
        int c = col - 6144;
        float* d = modf + (size_t)row * 2048 + c;
#pragma unroll
        for (int i = 0; i < 8; ++i) d[i] = v[i] + b_adaf[c + i];
      }
    });
  }
}

__device__ void phase_norm(const P& p, int which) {
  const int lane = threadIdx.x & 63, wid = threadIdx.x >> 6;
  const float* mod = (const float*)(p.ws + OFF_MOD);
  const bf16_t* x1 = (const bf16_t*)(p.ws + OFF_XBC);
  bf16_t* hout = (bf16_t*)(p.ws + OFF_ACT);
  const float* g = which ? p.in[11] : p.in[10];
  for (int t = blockIdx.x * 4 + wid; t < TT; t += gridDim.x * 4) {
    const float* md = mod + (size_t)mrow(t) * 6144 + (which ? 3072 : 0);
    float v[16];
    if (which) {
      const bf16_t* xr = x1 + (size_t)t * 1024;
      uint4 a = *(const uint4*)(xr + lane * 8), c = *(const uint4*)(xr + 512 + lane * 8);
      float f0[8], f1[8];
      unpack8(a, f0); unpack8(c, f1);
#pragma unroll
      for (int i = 0; i < 8; ++i) { v[i] = f0[i]; v[8 + i] = f1[i]; }
    } else {
      const float* xr = (t < TP ? p.in[0] + (size_t)t * 1024 : p.in[1] + (size_t)(t - TP) * 1024);
      float4 a = *(const float4*)(xr + lane * 8), b = *(const float4*)(xr + lane * 8 + 4);
      float4 c = *(const float4*)(xr + 512 + lane * 8), d = *(const float4*)(xr + 512 + lane * 8 + 4);
      v[0] = a.x; v[1] = a.y; v[2] = a.z; v[3] = a.w; v[4] = b.x; v[5] = b.y; v[6] = b.z; v[7] = b.w;
      v[8] = c.x; v[9] = c.y; v[10] = c.z; v[11] = c.w; v[12] = d.x; v[13] = d.y; v[14] = d.z; v[15] = d.w;
    }
    float ss = 0.f;
#pragma unroll
    for (int i = 0; i < 16; ++i) ss += v[i] * v[i];
    ss = wave_sum(ss);
    float rs = rsqrtf(ss * (1.f / 1024.f) + 1e-6f);
#pragma unroll
    for (int hf = 0; hf < 2; ++hf) {
      int c0 = hf * 512 + lane * 8;
      float o[8];
#pragma unroll
      for (int i = 0; i < 8; ++i) {
        int c = c0 + i;
        o[i] = v[hf * 8 + i] * rs * g[c] * (1.f + md[1024 + c]) + md[c];
      }
      store8bf(hout + (size_t)t * 1024 + c0, o);
    }
  }
}

__device__ void phase_inproj(const P& p, char* smem) {
  const bf16_t* h = (const bf16_t*)(p.ws + OFF_ACT);
  const bf16_t* WinT = (const bf16_t*)(p.ws + OFF_WINT);
  bf16_t* u = (bf16_t*)(p.ws + OFF_U);
  bf16_t* z = (bf16_t*)(p.ws + OFF_Z);
  bf16_t* xbc = (bf16_t*)(p.ws + OFF_XBC);
  bf16_t* gates = (bf16_t*)(p.ws + OFF_GATES);
  float* dtb = (float*)(p.ws + OFF_DTB);
  const float* dt_bias = p.in[26];
  float* out = p.out;
  for (int tile = blockIdx.x; tile < 129 * 23; tile += gridDim.x) {
    const int mt = tile / 23, nt2 = tile % 23;
    f32x4 acc[4][8];
    zero_acc8(acc);
    gemm_kloop_n256(h + (size_t)mt * 128 * 1024, 1024, WinT + (size_t)nt2 * 256 * 1024, 1024, acc, smem);
    stage_all_bf16(acc, smem);
#pragma unroll 1
   for (int hh = 0; hh < 2; ++hh) {
    const int nt = nt2 * 2 + hh;
    if (nt >= 12 && nt < 28 && mt < 128) {
      const int tid = threadIdx.x;
      const bf16_t* Cs = (const bf16_t*)smem;
      const int c8 = (tid & 15) * 8;
      const int ch = nt * 128 - 1536 + c8;
      const int cc = hh * 128 + c8;
      const float* cw = p.in[24];
      const float* cbias = p.in[25];
      float wk[4][8], bias[8];
#pragma unroll
      for (int k = 0; k < 4; ++k) {
        float4 a = *(const float4*)(cw + k * 2048 + ch), b = *(const float4*)(cw + k * 2048 + ch + 4);
        wk[k][0] = a.x; wk[k][1] = a.y; wk[k][2] = a.z; wk[k][3] = a.w; wk[k][4] = b.x; wk[k][5] = b.y; wk[k][6] = b.z; wk[k][7] = b.w;
      }
      {
        float4 a = *(const float4*)(cbias + ch), b = *(const float4*)(cbias + ch + 4);
        bias[0] = a.x; bias[1] = a.y; bias[2] = a.z; bias[3] = a.w; bias[4] = b.x; bias[5] = b.y; bias[6] = b.z; bias[7] = b.w;
      }
      const bool seq_start = ((mt & 15) == 0);
      bf16_t* tails = (bf16_t*)(p.ws + OFF_TAILS);
#pragma unroll 1
      for (int i = 0; i < 8; ++i) {
        const int row = (tid >> 4) + 16 * i;
        const int grow = mt * 128 + row;
        float cur[8];
        cs16_load8(Cs, row, cc, cur);
        if (row >= 125) store8bf(tails + ((size_t)mt * 3 + (row - 125)) * 2048 + ch, cur);
        {
          const int l = grow & 2047;
          if (l >= 2045) {
            float* o = out + O_CONV_P + ((size_t)(grow >> 11) * 3 + (l - 2045)) * 2048 + ch;
            *(float4*)o = make_float4(cur[0], cur[1], cur[2], cur[3]);
            *(float4*)(o + 4) = make_float4(cur[4], cur[5], cur[6], cur[7]);
          }
        }
        if (row < 3 && !seq_start) {
          store8bf(xbc + (size_t)grow * 2048 + ch, cur);
        } else {
          float a[8];
#pragma unroll
          for (int q = 0; q < 8; ++q) a[q] = bias[q] + wk[3][q] * cur[q];
#pragma unroll
          for (int k = 0; k < 3; ++k) {
            const int rr = row - 3 + k;
            if (rr >= 0) {
              float pv[8];
              cs16_load8(Cs, rr, cc, pv);
#pragma unroll
              for (int q = 0; q < 8; ++q) a[q] += wk[k][q] * pv[q];
            }
          }
#pragma unroll
          for (int q = 0; q < 8; ++q) a[q] = siluf(a[q]);
          store8bf(xbc + (size_t)grow * 2048 + ch, a);
        }
      }
      continue;
    }
    epi_pass16(smem, hh, mt * 128, nt * 128, [&](int row, int col, const float (&v)[8]) {
      if (col < 512) {
        store8bf(u + (size_t)row * 512 + col, v);
      } else if (col < 1536) {
        store8bf(z + (size_t)row * 1024 + (col - 512), v);
      } else if (col < 3584) {
        int ch = col - 1536;
        store8bf(xbc + (size_t)row * 2048 + ch, v);
        float* o = nullptr;
        if (row >= TP) o = out + O_CONV_S + ((size_t)(row - TP) * 3 + 2) * 2048 + ch;
        else { int l = row & 2047; if (l >= 2045) o = out + O_CONV_P + ((size_t)(row >> 11) * 3 + (l - 2045)) * 2048 + ch; }
        if (o) { *(float4*)o = make_float4(v[0], v[1], v[2], v[3]); *(float4*)(o + 4) = make_float4(v[4], v[5], v[6], v[7]); }
      } else if (col < 5632) {
        float s[8];
#pragma unroll
        for (int i = 0; i < 8; ++i) s[i] = sigmf(v[i]);
        store8bf(gates + (size_t)row * 2048 + (col - 3584), s);
      } else if (col < 5648) {
#pragma unroll
        for (int i = 0; i < 8; ++i) {
          int hh = col - 5632 + i;
          float x = v[i] + dt_bias[hh];
          dtb[(size_t)row * 16 + hh] = (x > 20.f) ? x : log1pf(expf(x));
        }
      }
    });
   }
    __syncthreads();
  }
}

__device__ void phase_convfix(const P& p) {
  bf16_t* xbc = (bf16_t*)(p.ws + OFF_XBC);
  const bf16_t* tails = (const bf16_t*)(p.ws + OFF_TAILS);
  const float* cw = p.in[24];
  const float* cbias = p.in[25];
  const int ch = threadIdx.x * 8;
  for (int mt = blockIdx.x + 1; mt < 128; mt += gridDim.x) {
    if ((mt & 15) == 0) continue;
    float raw[6][8];
#pragma unroll
    for (int r = 0; r < 3; ++r) {
      uint4 a = *(const uint4*)(tails + ((size_t)(mt - 1) * 3 + r) * 2048 + ch);
      uint4 b = *(const uint4*)(xbc + ((size_t)mt * 128 + r) * 2048 + ch);
      unpack8(a, raw[r]); unpack8(b, raw[3 + r]);
    }
    float wk[4][8], bias[8];
#pragma unroll
    for (int k = 0; k < 4; ++k) {
      float4 a = *(const float4*)(cw + k * 2048 + ch), b = *(const float4*)(cw + k * 2048 + ch + 4);
      wk[k][0] = a.x; wk[k][1] = a.y; wk[k][2] = a.z; wk[k][3] = a.w; wk[k][4] = b.x; wk[k][5] = b.y; wk[k][6] = b.z; wk[k][7] = b.w;
    }
    {
      float4 a = *(const float4*)(cbias + ch), b = *(const float4*)(cbias + ch + 4);
      bias[0] = a.x; bias[1] = a.y; bias[2] = a.z; bias[3] = a.w; bias[4] = b.x; bias[5] = b.y; bias[6] = b.z; bias[7] = b.w;
    }
#pragma unroll
    for (int r = 0; r < 3; ++r) {
      float o[8];
#pragma unroll
      for (int q = 0; q < 8; ++q)
        o[q] = siluf(bias[q] + wk[0][q] * raw[r][q] + wk[1][q] * raw[r + 1][q] + wk[2][q] * raw[r + 2][q] + wk[3][q] * raw[r + 3][q]);
      store8bf(xbc + ((size_t)mt * 128 + r) * 2048 + ch, o);
    }
  }
}

__device__ void ssd_prompt_item(const P& p, char* smem, int b, int h) {
  const int tid = threadIdx.x, lane = tid & 63, w = tid >> 6, fr = lane & 15, fq = lane >> 4;
  const int g = h >> 2;
  bf16_t* Cm = (bf16_t*)(smem);
  bf16_t* Bm = (bf16_t*)(smem + 17408);
  bf16_t* Wb = Bm;
  bf16_t* BmT = (bf16_t*)(smem + 34816);
  bf16_t* XT = (bf16_t*)(smem + 53248);
  bf16_t* Hp = (bf16_t*)(smem + 62464);
  float* dts = (float*)(smem + 79872);
  float* css = (float*)(smem + 80128);
  const bf16_t* xbc = (const bf16_t*)(p.ws + OFF_XBC);
  const bf16_t* zb = (const bf16_t*)(p.ws + OFF_Z);
  const float* dtb = (const float*)(p.ws + OFF_DTB);
  bf16_t* yssd = (bf16_t*)(p.ws + OFF_YSSD);
  const float a_h = -expf(p.in[27][h]);
  const float Dh = p.in[28][h];
  for (int i = tid; i < 64 * 136 / 2; i += 256) ((unsigned*)Hp)[i] = 0u;
  f32x4 st[8];
#pragma unroll
  for (int n = 0; n < 8; ++n) st[n] = f32x4{0.f, 0.f, 0.f, 0.f};
  __syncthreads();
  const int xc4 = tid & 15, xj0 = (tid >> 4) * 4;
  const int bc4a = tid & 31, bj0a = (tid >> 5) * 4;
  const int bj0b = bj0a + 32;
  uint2 px[4], pb0[4], pb1[4], pc0[4], pc1[4];
  float pdt = 0.f;
  auto issue_loads = [&](int c) __attribute__((always_inline)) {
    const size_t r0 = (size_t)(b * 2048 + c * 64);
#pragma unroll
    for (int r = 0; r < 4; ++r) {
      px[r] = *(const uint2*)(xbc + (r0 + xj0 + r) * 2048 + h * 64 + xc4 * 4);
      pb0[r] = *(const uint2*)(xbc + (r0 + bj0a + r) * 2048 + 1024 + g * 128 + bc4a * 4);
      pb1[r] = *(const uint2*)(xbc + (r0 + bj0b + r) * 2048 + 1024 + g * 128 + bc4a * 4);
      pc0[r] = *(const uint2*)(xbc + (r0 + bj0a + r) * 2048 + 1536 + g * 128 + bc4a * 4);
      pc1[r] = *(const uint2*)(xbc + (r0 + bj0b + r) * 2048 + 1536 + g * 128 + bc4a * 4);
    }
    if (w == 0) pdt = dtb[(r0 + lane) * 16 + h];
  };
  issue_loads(0);
#pragma unroll 1
  for (int c = 0; c < 32; ++c) {
    const int t0 = b * 2048 + c * 64;
    if (w == 0) {
      float dt = pdt;
      float s = wave_incl_scan(dt * a_h);
      dts[lane] = dt;
      css[lane] = s;
    }
    __syncthreads();
    const float cs_last = css[63];
    {
      *(uint2*)(XT + (xc4 * 4 + 0) * 72 + xj0) = make_uint2((px[0].x & 0xffffu) | (px[1].x << 16), (px[2].x & 0xffffu) | (px[3].x << 16));
      *(uint2*)(XT + (xc4 * 4 + 1) * 72 + xj0) = make_uint2((px[0].x >> 16) | (px[1].x & 0xffff0000u), (px[2].x >> 16) | (px[3].x & 0xffff0000u));
      *(uint2*)(XT + (xc4 * 4 + 2) * 72 + xj0) = make_uint2((px[0].y & 0xffffu) | (px[1].y << 16), (px[2].y & 0xffffu) | (px[3].y << 16));
      *(uint2*)(XT + (xc4 * 4 + 3) * 72 + xj0) = make_uint2((px[0].y >> 16) | (px[1].y & 0xffff0000u), (px[2].y >> 16) | (px[3].y & 0xffff0000u));
#pragma unroll
      for (int r = 0; r < 4; ++r) {
        *(uint2*)(Bm + (bj0a + r) * 136 + bc4a * 4) = pb0[r];
        *(uint2*)(Bm + (bj0b + r) * 136 + bc4a * 4) = pb1[r];
        *(uint2*)(Cm + (bj0a + r) * 136 + bc4a * 4) = pc0[r];
        *(uint2*)(Cm + (bj0b + r) * 136 + bc4a * 4) = pc1[r];
      }
      float sa[4], sb[4];
#pragma unroll
      for (int r = 0; r < 4; ++r) {
        sa[r] = dts[bj0a + r] * __expf(cs_last - css[bj0a + r]);
        sb[r] = dts[bj0b + r] * __expf(cs_last - css[bj0b + r]);
      }
      *(uint2*)(BmT + (bc4a * 4 + 0) * 72 + bj0a) = make_uint2(cvtpk(bflo(pb0[0].x) * sa[0], bflo(pb0[1].x) * sa[1]), cvtpk(bflo(pb0[2].x) * sa[2], bflo(pb0[3].x) * sa[3]));
      *(uint2*)(BmT + (bc4a * 4 + 1) * 72 + bj0a) = make_uint2(cvtpk(bfhi(pb0[0].x) * sa[0], bfhi(pb0[1].x) * sa[1]), cvtpk(bfhi(pb0[2].x) * sa[2], bfhi(pb0[3].x) * sa[3]));
      *(uint2*)(BmT + (bc4a * 4 + 2) * 72 + bj0a) = make_uint2(cvtpk(bflo(pb0[0].y) * sa[0], bflo(pb0[1].y) * sa[1]), cvtpk(bflo(pb0[2].y) * sa[2], bflo(pb0[3].y) * sa[3]));
      *(uint2*)(BmT + (bc4a * 4 + 3) * 72 + bj0a) = make_uint2(cvtpk(bfhi(pb0[0].y) * sa[0], bfhi(pb0[1].y) * sa[1]), cvtpk(bfhi(pb0[2].y) * sa[2], bfhi(pb0[3].y) * sa[3]));
      *(uint2*)(BmT + (bc4a * 4 + 0) * 72 + bj0b) = make_uint2(cvtpk(bflo(pb1[0].x) * sb[0], bflo(pb1[1].x) * sb[1]), cvtpk(bflo(pb1[2].x) * sb[2], bflo(pb1[3].x) * sb[3]));
      *(uint2*)(BmT + (bc4a * 4 + 1) * 72 + bj0b) = make_uint2(cvtpk(bfhi(pb1[0].x) * sb[0], bfhi(pb1[1].x) * sb[1]), cvtpk(bfhi(pb1[2].x) * sb[2], bfhi(pb1[3].x) * sb[3]));
      *(uint2*)(BmT + (bc4a * 4 + 2) * 72 + bj0b) = make_uint2(cvtpk(bflo(pb1[0].y) * sb[0], bflo(pb1[1].y) * sb[1]), cvtpk(bflo(pb1[2].y) * sb[2], bflo(pb1[3].y) * sb[3]));
      *(uint2*)(BmT + (bc4a * 4 + 3) * 72 + bj0b) = make_uint2(cvtpk(bfhi(pb1[0].y) * sb[0], bfhi(pb1[1].y) * sb[1]), cvtpk(bfhi(pb1[2].y) * sb[2], bfhi(pb1[3].y) * sb[3]));
    }
    if (c + 1 < 32) issue_loads(c + 1);
    __syncthreads();
    f32x4 cbv[4];
#pragma unroll
    for (int jt = 0; jt < 4; ++jt) cbv[jt] = f32x4{0.f, 0.f, 0.f, 0.f};
#pragma unroll
    for (int ks = 0; ks < 4; ++ks) {
      bf16x8 a = *(const bf16x8*)(Cm + (16 * w + fr) * 136 + ks * 32 + fq * 8);
#pragma unroll
      for (int jt = 0; jt < 4; ++jt) {
        bf16x8 bb = *(const bf16x8*)(Bm + (jt * 16 + fr) * 136 + ks * 32 + fq * 8);
        cbv[jt] = __builtin_amdgcn_mfma_f32_16x16x32_bf16(a, bb, cbv[jt], 0, 0, 0);
      }
    }
    __syncthreads();
#pragma unroll
    for (int jt = 0; jt < 4; ++jt)
#pragma unroll
      for (int r = 0; r < 4; ++r) {
        int i = 16 * w + 4 * fq + r, j = jt * 16 + fr;
        float val = 0.f;
        if (j <= i) val = cbv[jt][r] * __expf(css[i] - css[j]) * dts[j];
        Wb[i * 72 + j] = f2bf(val);
      }
    __syncthreads();
    {
      f32x4 yd[4], yo[4];
#pragma unroll
      for (int mt = 0; mt < 4; ++mt) { yd[mt] = f32x4{0.f, 0.f, 0.f, 0.f}; yo[mt] = f32x4{0.f, 0.f, 0.f, 0.f}; }
#pragma unroll
      for (int ks = 0; ks < 2; ++ks) {
        bf16x8 bb = *(const bf16x8*)(XT + (16 * w + fr) * 72 + ks * 32 + fq * 8);
#pragma unroll
        for (int mt = 0; mt < 4; ++mt) {
          bf16x8 a = *(const bf16x8*)(Wb + (mt * 16 + fr) * 72 + ks * 32 + fq * 8);
          yd[mt] = __builtin_amdgcn_mfma_f32_16x16x32_bf16(a, bb, yd[mt], 0, 0, 0);
        }
      }
#pragma unroll
      for (int ks = 0; ks < 4; ++ks) {
        bf16x8 bb = *(const bf16x8*)(Hp + (16 * w + fr) * 136 + ks * 32 + fq * 8);
#pragma unroll
        for (int mt = 0; mt < 4; ++mt) {
          bf16x8 a = *(const bf16x8*)(Cm + (mt * 16 + fr) * 136 + ks * 32 + fq * 8);
          yo[mt] = __builtin_amdgcn_mfma_f32_16x16x32_bf16(a, bb, yo[mt], 0, 0, 0);
        }
      }
      const int pp = 16 * w + fr;
#pragma unroll
      for (int mt = 0; mt < 4; ++mt)
#pragma unroll
        for (int r = 0; r < 4; ++r) {
          int i = mt * 16 + 4 * fq + r;
          float yv = yd[mt][r] + __expf(css[i]) * yo[mt][r] + Dh * bf2f(XT[pp * 72 + i]);
          size_t off = (size_t)(t0 + i) * 1024 + h * 64 + pp;
          yssd[off] = f2bf(yv);
        }
    }
    {
      const float dec = __expf(cs_last);
#pragma unroll
      for (int n = 0; n < 8; ++n) { st[n][0] *= dec; st[n][1] *= dec; st[n][2] *= dec; st[n][3] *= dec; }
#pragma unroll
      for (int ks = 0; ks < 2; ++ks) {
        bf16x8 a = *(const bf16x8*)(XT + (16 * w + fr) * 72 + ks * 32 + fq * 8);
#pragma unroll
        for (int n = 0; n < 8; ++n) {
          bf16x8 bb = *(const bf16x8*)(BmT + (n * 16 + fr) * 72 + ks * 32 + fq * 8);
          st[n] = __builtin_amdgcn_mfma_f32_16x16x32_bf16(a, bb, st[n], 0, 0, 0);
        }
      }
#pragma unroll
      for (int n = 0; n < 8; ++n)
#pragma unroll
        for (int r = 0; r < 4; ++r) Hp[(16 * w + 4 * fq + r) * 136 + n * 16 + fr] = f2bf(st[n][r]);
    }
    __syncthreads();
  }
  float* so = p.out + O_SSM_P + ((size_t)(b * 16 + h) * 64) * 128;
#pragma unroll
  for (int n = 0; n < 8; ++n)
#pragma unroll
    for (int r = 0; r < 4; ++r) so[(size_t)(16 * w + 4 * fq + r) * 128 + n * 16 + fr] = st[n][r];
}

struct S5Par { float ar, ai; };
DI void s5_abar(const P& p, int g, int pp, float& abr, float& abi, float& fre, float& fim) {
  float dt = expf(p.in[15][g]);
  float ar = p.in[13][g * 64 + pp], ai = p.in[14][g * 64 + pp];
  float mag = expf(dt * ar);
  float sn, cs;
  sincosf(dt * ai, &sn, &cs);
  abr = mag * cs; abi = mag * sn;
  float den = ar * ar + ai * ai;
  float nr = abr - 1.f;
  fre = (nr * ar + abi * ai) / den;
  fim = (abi * ar - nr * ai) / den;
}

__device__ void s5_prompt_item(const P& p, char* smem, int b, int g4) {
  const int tid = threadIdx.x, lane = tid & 63, w = tid >> 6;
  const int g = g4 * 4 + w;
  const int r31 = lane & 31, hh = lane >> 5, fr = lane & 15, fq = lane >> 4;
  bf16_t* Sl = (bf16_t*)(smem + w * 8704);
  const bf16_t* ub = (const bf16_t*)(p.ws + OFF_U);
  bf16_t* ys5 = (bf16_t*)(p.ws + OFF_YS5);
  float a1r[2], a1i[2], a2r[2], a2i[2], a3r[2], a3i[2], a4r[2], a4i[2];
  bf16x8 bfrag[4];
#pragma unroll
  for (int pi = 0; pi < 2; ++pi) {
    int pp = pi * 32 + r31;
    float fre, fim;
    s5_abar(p, g, pp, a1r[pi], a1i[pi], fre, fim);
    a2r[pi] = a1r[pi] * a1r[pi] - a1i[pi] * a1i[pi]; a2i[pi] = 2.f * a1r[pi] * a1i[pi];
    a3r[pi] = a2r[pi] * a1r[pi] - a2i[pi] * a1i[pi]; a3i[pi] = a2r[pi] * a1i[pi] + a2i[pi] * a1r[pi];
    a4r[pi] = a2r[pi] * a2r[pi] - a2i[pi] * a2i[pi]; a4i[pi] = 2.f * a2r[pi] * a2i[pi];
    const float* br = p.in[16] + ((size_t)(g * 64 + pp)) * 16 + hh * 8;
    const float* bi = p.in[17] + ((size_t)(g * 64 + pp)) * 16 + hh * 8;
    float vr[8], vi[8];
#pragma unroll
    for (int j = 0; j < 8; ++j) {
      vr[j] = fre * br[j] - fim * bi[j];
      vi[j] = fre * bi[j] + fim * br[j];
    }
    bfrag[pi] = mk8(cvtpk(vr[0], vr[1]), cvtpk(vr[2], vr[3]), cvtpk(vr[4], vr[5]), cvtpk(vr[6], vr[7]));
    bfrag[2 + pi] = mk8(cvtpk(vi[0], vi[1]), cvtpk(vi[2], vi[3]), cvtpk(vi[4], vi[5]), cvtpk(vi[6], vi[7]));
  }
  bf16x8 cfrag[4];
#pragma unroll
  for (int ks = 0; ks < 4; ++ks) {
    int k0 = 32 * ks + 8 * fq;
    float v[8];
#pragma unroll
    for (int j = 0; j < 8; ++j) {
      int k = k0 + j;
      v[j] = (k < 64) ? p.in[18][((size_t)(g * 16 + fr)) * 64 + k] : -p.in[19][((size_t)(g * 16 + fr)) * 64 + (k - 64)];
    }
    cfrag[ks] = mk8(cvtpk(v[0], v[1]), cvtpk(v[2], v[3]), cvtpk(v[4], v[5]), cvtpk(v[6], v[7]));
  }
  const float dsk = p.in[20][g * 16 + fr];
  float Sr[2] = {0.f, 0.f}, Si[2] = {0.f, 0.f};
  const size_t tbase = (size_t)b * 2048;
  bf16x8 afr_n = *(const bf16x8*)(ub + (tbase + r31) * 512 + g * 16 + hh * 8);
  bf16_t uv_n[8];
#pragma unroll
  for (int q = 0; q < 8; ++q) uv_n[q] = ub[(tbase + (q >> 2) * 16 + 4 * fq + (q & 3)) * 512 + g * 16 + fr];
#pragma unroll 1
  for (int c = 0; c < 64; ++c) {
    const size_t t0 = tbase + c * 32;
    const bf16x8 afr = afr_n;
    bf16_t uv_c[8];
#pragma unroll
    for (int q = 0; q < 8; ++q) uv_c[q] = uv_n[q];
    if (c + 1 < 64) {
      afr_n = *(const bf16x8*)(ub + (t0 + 32 + r31) * 512 + g * 16 + hh * 8);
#pragma unroll
      for (int q = 0; q < 8; ++q) uv_n[q] = ub[(t0 + 32 + (q >> 2) * 16 + 4 * fq + (q & 3)) * 512 + g * 16 + fr];
    }
    f32x16 acc[4];
#pragma unroll
    for (int ct = 0; ct < 4; ++ct) {
#pragma unroll
      for (int q = 0; q < 16; ++q) acc[ct][q] = 0.f;
      acc[ct] = __builtin_amdgcn_mfma_f32_32x32x16_bf16(afr, bfrag[ct], acc[ct], 0, 0, 0);
    }
#pragma unroll
    for (int pi = 0; pi < 2; ++pi) {
      float sre[16], sim[16];
#pragma unroll
      for (int q = 0; q < 16; ++q) { sre[q] = acc[pi][q]; sim[q] = acc[2 + pi][q]; }
#pragma unroll
      for (int k = 0; k < 4; ++k)
#pragma unroll
        for (int i = 1; i < 4; ++i) {
          int q = 4 * k + i;
          float nr = sre[q] + a1r[pi] * sre[q - 1] - a1i[pi] * sim[q - 1];
          float ni = sim[q] + a1r[pi] * sim[q - 1] + a1i[pi] * sre[q - 1];
          sre[q] = nr; sim[q] = ni;
        }
      float Pr[4], Pi[4];
#pragma unroll
      for (int k = 0; k < 4; ++k) { Pr[k] = __shfl_xor(sre[4 * k + 3], 32); Pi[k] = __shfl_xor(sim[4 * k + 3], 32); }
      float cr = Sr[pi], ci = Si[pi];
      float cinr[4], cini[4];
#pragma unroll
      for (int G = 0; G < 8; ++G) {
        const int k = G >> 1;
        const bool mine = ((G & 1) == hh);
        if ((G & 1) == 0) { cinr[k] = cr; cini[k] = ci; }
        else { cinr[k] = mine ? cr : cinr[k]; cini[k] = mine ? ci : cini[k]; }
        float fr_ = mine ? sre[4 * k + 3] : Pr[k];
        float fi_ = mine ? sim[4 * k + 3] : Pi[k];
        float nr = a4r[pi] * cr - a4i[pi] * ci + fr_;
        float ni = a4r[pi] * ci + a4i[pi] * cr + fi_;
        cr = nr; ci = ni;
      }
      Sr[pi] = cr; Si[pi] = ci;
#pragma unroll
      for (int k = 0; k < 4; ++k) {
        const float pwr[4] = {a1r[pi], a2r[pi], a3r[pi], a4r[pi]};
        const float pwi[4] = {a1i[pi], a2i[pi], a3i[pi], a4i[pi]};
#pragma unroll
        for (int i = 0; i < 4; ++i) {
          int q = 4 * k + i;
          float vr = sre[q] + pwr[i] * cinr[k] - pwi[i] * cini[k];
          float vi = sim[q] + pwr[i] * cini[k] + pwi[i] * cinr[k];
          int tok = i + 8 * k + 4 * hh;
          Sl[tok * 136 + pi * 32 + r31] = f2bf(vr);
          Sl[tok * 136 + 64 + pi * 32 + r31] = f2bf(vi);
        }
      }
    }
    __syncthreads();
    f32x4 yacc[2];
#pragma unroll
    for (int mt = 0; mt < 2; ++mt) {
      yacc[mt] = f32x4{0.f, 0.f, 0.f, 0.f};
#pragma unroll
      for (int ks = 0; ks < 4; ++ks) {
        bf16x8 a = *(const bf16x8*)(Sl + (mt * 16 + fr) * 136 + ks * 32 + fq * 8);
        yacc[mt] = __builtin_amdgcn_mfma_f32_16x16x32_bf16(a, cfrag[ks], yacc[mt], 0, 0, 0);
      }
    }
#pragma unroll
    for (int mt = 0; mt < 2; ++mt)
#pragma unroll
      for (int r = 0; r < 4; ++r) {
        int tok = mt * 16 + 4 * fq + r;
        size_t off = (t0 + tok) * 512 + g * 16 + fr;
        float uv = bf2f(uv_c[mt * 4 + r]);
        ys5[off] = f2bf(geluf(yacc[mt][r] + dsk * uv));
      }
    __syncthreads();
  }
  if (hh == 0) {
#pragma unroll
    for (int pi = 0; pi < 2; ++pi) {
      p.out[O_S5RE_P + (size_t)(b * 32 + g) * 64 + pi * 32 + r31] = Sr[pi];
      p.out[O_S5IM_P + (size_t)(b * 32 + g) * 64 + pi * 32 + r31] = Si[pi];
    }
  }
}

__device__ void s5_sample_item(const P& p, int item) {
  const int lane = threadIdx.x & 63, w = threadIdx.x >> 6;
  const bf16_t* ub = (const bf16_t*)(p.ws + OFF_U);
  bf16_t* ys5 = (bf16_t*)(p.ws + OFF_YS5);
  const int b = item >> 3;
  const int g = (item & 7) * 4 + w;
  const size_t t = TP + b;
  float abr, abi, fre, fim;
  s5_abar(p, g, lane, abr, abi, fre, fim);
  float uv[16];
  {
    uint4 u0 = *(const uint4*)(ub + t * 512 + g * 16), u1 = *(const uint4*)(ub + t * 512 + g * 16 + 8);
    float t0[8], t1[8];
    unpack8(u0, t0); unpack8(u1, t1);
#pragma unroll
    for (int i = 0; i < 8; ++i) { uv[i] = t0[i]; uv[8 + i] = t1[i]; }
  }
  float cr[16], cm[16], dsk[16];
#pragma unroll
  for (int hx = 0; hx < 16; ++hx) {
    cr[hx] = p.in[18][((size_t)(g * 16 + hx)) * 64 + lane];
    cm[hx] = p.in[19][((size_t)(g * 16 + hx)) * 64 + lane];
    dsk[hx] = p.in[20][g * 16 + hx];
  }
  const float* br = p.in[16] + ((size_t)(g * 64 + lane)) * 16;
  const float* bi = p.in[17] + ((size_t)(g * 64 + lane)) * 16;
  float bur = 0.f, bui = 0.f;
#pragma unroll
  for (int hx = 0; hx < 16; ++hx) {
    float bbr = fre * br[hx] - fim * bi[hx];
    float bbi = fre * bi[hx] + fim * br[hx];
    bur += bbr * uv[hx]; bui += bbi * uv[hx];
  }
  float s0r = p.in[2][((size_t)b * 32 + g) * 64 + lane], s0i = p.in[3][((size_t)b * 32 + g) * 64 + lane];
  float sr = abr * s0r - abi * s0i + bur;
  float si = abr * s0i + abi * s0r + bui;
  p.out[O_S5RE_S + ((size_t)b * 32 + g) * 64 + lane] = sr;
  p.out[O_S5IM_S + ((size_t)b * 32 + g) * 64 + lane] = si;
  float myy = 0.f;
#pragma unroll
  for (int hx = 0; hx < 16; ++hx) {
    float v = wave_sum_fast(cr[hx] * sr - cm[hx] * si);
    if (lane == hx) myy = v + dsk[hx] * uv[hx];
  }
  if (lane < 16) ys5[t * 512 + g * 16 + lane] = f2bf(geluf(myy));
}

__device__ void ssd_sample_item(const P& p, char* smem, int b, int g) {
  const int tid = threadIdx.x, lane = tid & 63, w = tid >> 6;
  float* xs = (float*)smem;
  float* Bs = xs + 256;
  float* Cs = Bs + 128;
  float* ybuf = Cs + 128;
  float* red = ybuf + 256;
  const size_t t = TP + b;
  const bf16_t* xbc = (const bf16_t*)(p.ws + OFF_XBC);
  const bf16_t* zb = (const bf16_t*)(p.ws + OFF_Z);
  const float* dtb = (const float*)(p.ws + OFF_DTB);
  bf16_t* yb = (bf16_t*)(p.ws + OFF_YSSD);
  const float* cw = p.in[24];
  const float* cbias = p.in[25];
  const float* sconv = p.in[5] + (size_t)b * 3 * 2048;
  {
#pragma unroll
    for (int part = 0; part < 2; ++part) {
      int ch = part == 0 ? (g * 256 + tid) : (tid < 128 ? 1024 + g * 128 + tid : 1536 + g * 128 + (tid - 128));
      float a = cbias[ch] + cw[ch] * sconv[ch] + cw[2048 + ch] * sconv[2048 + ch] + cw[4096 + ch] * sconv[4096 + ch]
                + cw[6144 + ch] * bf2f(xbc[t * 2048 + ch]);
      a = siluf(a);
      if (part == 0) xs[tid] = a; else Bs[tid] = a;
    }
  }
  __syncthreads();
  const int h = g * 4 + w;
  const float dt = dtb[t * 16 + h];
  const float a_h = -expf(p.in[27][h]);
  const float dA = __expf(dt * a_h);
  const float* h0 = p.in[4] + ((size_t)(b * 16 + h) * 64) * 128;
  float* hn = p.out + O_SSM_S + ((size_t)(b * 16 + h) * 64) * 128;
  const int n4 = (lane & 31) * 4;
  const float4 Bv = *(const float4*)(Bs + n4);
  const float4 Cv = *(const float4*)(Cs + n4);
#pragma unroll 4
  for (int it = 0; it < 32; ++it) {
    int pp = 2 * it + (lane >> 5);
    float4 hv = *(const float4*)(h0 + (size_t)pp * 128 + n4);
    float xd = dt * xs[w * 64 + pp];
    float4 nv;
    nv.x = dA * hv.x + xd * Bv.x; nv.y = dA * hv.y + xd * Bv.y; nv.z = dA * hv.z + xd * Bv.z; nv.w = dA * hv.w + xd * Bv.w;
    *(float4*)(hn + (size_t)pp * 128 + n4) = nv;
    float part = Cv.x * nv.x + Cv.y * nv.y + Cv.z * nv.z + Cv.w * nv.w;
#pragma unroll
    for (int o = 16; o; o >>= 1) part += __shfl_xor(part, o);
    if ((lane & 31) == 0) ybuf[w * 64 + pp] = part;
  }
  __syncthreads();
  float y = ybuf[tid] + p.in[28][g * 4 + (tid >> 6)] * xs[tid];
  float zv = bf2f(zb[t * 1024 + g * 256 + tid]);
  y *= siluf(zv);
  float ss = wave_sum(y * y);
  if (lane == 0) red[w] = ss;
  __syncthreads();
  float tot = red[0] + red[1] + red[2] + red[3];
  float rs = rsqrtf(tot * (1.f / 256.f) + 1e-5f);
  yb[t * 1024 + g * 256 + tid] = f2bf(y * rs * p.in[29][g * 256 + tid]);
  __syncthreads();
}

__device__ void expert_convert_dynamic(const P& p, char* smem) {
  unsigned char* E8 = (unsigned char*)(p.ws + OFF_E8);
  float* Esc = (float*)(p.ws + OFF_E8 + 33554432);
  unsigned* counter = (unsigned*)(p.ws + OFF_BAR + 14336);
  const int tid = threadIdx.x, lane = tid & 63, wid = tid >> 6;
  int* stask = (int*)(smem + 64);
  for (;;) {
    __syncthreads();
    if (tid == 0) *stask = (int)atomicAdd(counter, 1u);
    __syncthreads();
    const int q = *stask;
    if (q >= 2048) break;
    const int tbl = (q >= 1024) ? 1 : 0;
    const float* src = tbl ? p.in[35] : p.in[34];
    const int row0 = (q & 1023) * 16 + wid * 4;
    float4 ld[4][4];
#pragma unroll
    for (int r = 0; r < 4; ++r) {
      const float* sp = src + (size_t)(row0 + r) * 1024 + lane * 16;
#pragma unroll
      for (int k = 0; k < 4; ++k) ld[r][k] = *(const float4*)(sp + 4 * k);
    }
#pragma unroll
    for (int r = 0; r < 4; ++r) {
      float am = 0.f;
#pragma unroll
      for (int k = 0; k < 4; ++k)
        am = fmaxf(am, fmaxf(fmaxf(fabsf(ld[r][k].x), fabsf(ld[r][k].y)), fmaxf(fabsf(ld[r][k].z), fabsf(ld[r][k].w))));
      am = wave_max(am);
      const float sc = (am > 0.f) ? am * (1.f / 448.f) : 1.f;
      const float inv = 1.f / sc;
      unsigned w[4];
#pragma unroll
      for (int k = 0; k < 4; ++k) {
        int t0 = __builtin_amdgcn_cvt_pk_fp8_f32(ld[r][k].x * inv, ld[r][k].y * inv, 0, false);
        t0 = __builtin_amdgcn_cvt_pk_fp8_f32(ld[r][k].z * inv, ld[r][k].w * inv, t0, true);
        w[k] = (unsigned)t0;
      }
      const int rowi = row0 + r;
      *(uint4*)(E8 + (size_t)tbl * 16777216 + (size_t)rowi * 1024 + lane * 16) = make_uint4(w[0], w[1], w[2], w[3]);
      if (lane == 0) Esc[tbl * 16384 + rowi] = sc;
    }
  }
  __syncthreads();
}

__device__ void late_weight_convert(const P& p, char* smem) {
  bf16_t* WgluT = (bf16_t*)(p.ws + OFF_WGLUT);
  bf16_t* WaT = (bf16_t*)(p.ws + OFF_WAT);
  bf16_t* WbT = (bf16_t*)(p.ws + OFF_WBT);
  bf16_t* WoutT = (bf16_t*)(p.ws + OFF_WOUTT);
  bf16_t* WqT = (bf16_t*)(p.ws + OFF_WQT);
  unsigned* counter = (unsigned*)(p.ws + OFF_BAR + 14400);
  int* stask = (int*)(smem + 20480);
  for (;;) {
    __syncthreads();
    if (threadIdx.x == 0) *stask = (int)atomicAdd(counter, 1u);
    __syncthreads();
    int t = *stask;
    if (t >= 1216) break;
    if (t < 64) { int nt = t >> 3, kt = t & 7; tconv_tile(p.in[21], 512, nt * 64, 64, kt * 64, WgluT, 512, nt * 64, smem); continue; }
    t -= 64;
    if (t < 128) { int nt = t >> 3, kt = t & 7; tconv_tile(p.in[23], 1024, nt * 64, 64, kt * 64, WaT, 512, nt * 64, smem); continue; }
    t -= 128;
    if (t < 256) { int nt = t >> 4, kt = t & 15; tconv_tile(p.in[30], 1024, nt * 64, 64, kt * 64, WbT, 1024, nt * 64, smem); continue; }
    t -= 256;
    if (t < 256) { int nt = t >> 4, kt = t & 15; tconv_tile(p.in[31], 1024, nt * 64, 64, kt * 64, WoutT, 1024, nt * 64, smem); continue; }
    t -= 256;
    { int nt = t >> 4, kt = t & 15; tconv_tile(p.in[32], 2048, nt * 64, 64, kt * 64, WqT, 1024, nt * 64, smem); }
  }
  __syncthreads();
}

__device__ void phase_mixers(const P& p, char* smem) {
  const int G = gridDim.x;
#pragma unroll 1
  for (int it = blockIdx.x; it < 128; it += G) { ssd_prompt_item(p, smem, it >> 4, it & 15); __syncthreads(); }
#pragma unroll 1
  for (int it = (blockIdx.x + G - 128 % G) % G; it < 64; it += G) { s5_prompt_item(p, smem, it >> 3, it & 7); __syncthreads(); }
  const bool wide = (G >= 512);
  const int bid = (int)blockIdx.x;
  const int wi = (bid >= 192 && bid < 256) ? bid - 192 : ((bid >= 384) ? bid - 384 + 64 : -1);
  const int nw = G - 320;
  const int ss_start = wide ? (wi >= 0 ? wi : 512) : (int)((blockIdx.x + G - 192 % G) % G);
  const int ss_step = wide ? nw : G;
#pragma unroll 1
  for (int it = ss_start; it < 512; it += ss_step) { ssd_sample_item(p, smem, it >> 2, it & 3); __syncthreads(); }
  const int s5s_start = wide ? (wi >= 0 ? wi : 1024) : (int)((blockIdx.x + G - 704 % G) % G);
#pragma unroll 1
  for (int it = s5s_start; it < 1024; it += ss_step) { s5_sample_item(p, it); __syncthreads(); }
  if (wide && bid >= 256 && bid < 384) return;
  late_weight_convert(p, smem);
  expert_convert_dynamic(p, smem);
}

__device__ void phase_glu(const P& p, char* smem) {
  const bf16_t* ys5 = (const bf16_t*)(p.ws + OFF_YS5);
  const bf16_t* WgluT = (const bf16_t*)(p.ws + OFF_WGLUT);
  bf16_t* ya = (bf16_t*)(p.ws + OFF_U);
  bf16_t* yb = (bf16_t*)(p.ws + OFF_YSSD);
  const bf16_t* zb = (const bf16_t*)(p.ws + OFF_Z);
  const float* bglu = p.in[22];
  const float* gn = p.in[29];
  const int lane = threadIdx.x & 63, wid = threadIdx.x >> 6;
  const int NT = 516 + 1024;
  const int G = gridDim.x;
  const int nextra = (G >= 512 && G < 516) ? 516 - G : 0;
  for (int k = 0;; ++k) {
    int task;
    if (nextra == 0) { task = (int)blockIdx.x + k * G; if (task >= NT) break; }
    else {
      const int b = (int)blockIdx.x;
      if (k == 0) task = b;
      else if (b < nextra) { if (k == 1) task = G + b; else break; }
      else { const int nt_ = (b - nextra) + (k - 1) * (G - nextra); if (nt_ >= 1024) break; task = 516 + nt_; }
    }
    if (task < 516) {
      int mt = task >> 2, nt = task & 3;
      f32x4 acc[4][4];
      zero_acc(acc);
      gemm_kloop(ys5 + (size_t)mt * 128 * 512, 512, WgluT + (size_t)nt * 128 * 512, 512, 512, acc, smem);
      gemm_epilogue(acc, smem, mt * 128, nt * 128, [&](int row, int col, const float (&v)[8]) {
        uint4 yv = *(const uint4*)(ys5 + (size_t)row * 512 + col);
        float y[8], o[8];
        unpack8(yv, y);
#pragma unroll
        for (int i = 0; i < 8; ++i) o[i] = y[i] * sigmf(v[i] + bglu[col + i]);
        store8bf(ya + (size_t)row * 512 + col, o);
      });
    } else {
      int base = (task - 516) * 16;
#pragma unroll 1
      for (int q = 0; q < 4; ++q) {
        size_t t = base + q * 4 + wid;
        bf16_t* rowp = yb + t * 1024 + lane * 16;
        const bf16_t* zp = zb + t * 1024 + lane * 16;
        uint4 a = *(const uint4*)rowp, b = *(const uint4*)(rowp + 8);
        uint4 za = *(const uint4*)zp, zb2 = *(const uint4*)(zp + 8);
        float v0[8], v1[8], z0[8], z1[8];
        unpack8(a, v0); unpack8(b, v1); unpack8(za, z0); unpack8(zb2, z1);
#pragma unroll
        for (int i = 0; i < 8; ++i) { v0[i] *= siluf(z0[i]); v1[i] *= siluf(z1[i]); }
        float ss = 0.f;
#pragma unroll
        for (int i = 0; i < 8; ++i) ss += v0[i] * v0[i] + v1[i] * v1[i];
#pragma unroll
        for (int o = 8; o; o >>= 1) ss += __shfl_xor(ss, o);
        float rs = rsqrtf(ss * (1.f / 256.f) + 1e-5f);
        const float* gp = gn + lane * 16;
#pragma unroll
        for (int i = 0; i < 8; ++i) { v0[i] *= rs * gp[i]; v1[i] *= rs * gp[8 + i]; }
        store8bf(rowp, v0);
        store8bf(rowp + 8, v1);
      }
    }
  }
}

__device__ void phase_merge(const P& p, char* smem) {
  const bf16_t* ya = (const bf16_t*)(p.ws + OFF_U);
  const bf16_t* yb = (const bf16_t*)(p.ws + OFF_YSSD);
  const bf16_t* WaT = (const bf16_t*)(p.ws + OFF_WAT);
  const bf16_t* WbT = (const bf16_t*)(p.ws + OFF_WBT);
  const bf16_t* gates = (const bf16_t*)(p.ws + OFF_GATES);
  bf16_t* tmp = (bf16_t*)(p.ws + OFF_XBC);
  bf16_t* merged = (bf16_t*)(p.ws + OFF_ACT);
  auto epiA = [&](int row, int col, const float (&v)[8]) {
    uint4 gv = *(const uint4*)(gates + (size_t)row * 2048 + col);
    float gg[8];
    unpack8(gv, gg);
    float o[8];
#pragma unroll
    for (int i = 0; i < 8; ++i) o[i] = gg[i] * v[i];
    store8bf(tmp + (size_t)row * 1024 + col, o);
  };
  auto epiB = [&](int row, int col, const float (&v)[8]) {
    uint4 gv = *(const uint4*)(gates + (size_t)row * 2048 + 1024 + col);
    float gg[8], o[8];
    unpack8(gv, gg);
    uint4 tv = *(const uint4*)(tmp + (size_t)row * 1024 + col);
    float tf[8];
    unpack8(tv, tf);
#pragma unroll
    for (int i = 0; i < 8; ++i) o[i] = tf[i] + gg[i] * v[i];
    store8bf(merged + (size_t)row * 1024 + col, o);
  };
#pragma unroll 1
  for (int tile = blockIdx.x; tile < 512; tile += gridDim.x) {
    const int mt = tile >> 2, nt2 = tile & 3;
    f32x4 acc[4][8];
    zero_acc8(acc);
    gemm_kloop_n256(ya + (size_t)mt * 128 * 512, 512, WaT + (size_t)nt2 * 256 * 512, 512, acc, smem);
    stage_all_bf16(acc, smem);
#pragma unroll 1
    for (int hh = 0; hh < 2; ++hh) epi_pass16(smem, hh, mt * 128, (nt2 * 2 + hh) * 128, epiA);
    __syncthreads();
  }
#pragma unroll 1
  for (int nt = blockIdx.x; nt < 8; nt += gridDim.x) {
    f32x4 acc[4][4];
    zero_acc(acc);
    gemm_kloop(ya + (size_t)TP * 512, 512, WaT + (size_t)nt * 128 * 512, 512, 512, acc, smem);
    gemm_epilogue(acc, smem, TP, nt * 128, epiA);
  }
#pragma unroll 1
  for (int tile = blockIdx.x; tile < 512; tile += gridDim.x) {
    const int mt = tile >> 2, nt2 = tile & 3;
    f32x4 acc[4][8];
    zero_acc8(acc);
    gemm_kloop_n256(yb + (size_t)mt * 128 * 1024, 1024, WbT + (size_t)nt2 * 256 * 1024, 1024, acc, smem);
    stage_all_bf16(acc, smem);
#pragma unroll 1
    for (int hh = 0; hh < 2; ++hh) epi_pass16(smem, hh, mt * 128, (nt2 * 2 + hh) * 128, epiB);
    __syncthreads();
  }
#pragma unroll 1
  for (int nt = blockIdx.x; nt < 8; nt += gridDim.x) {
    f32x4 acc[4][4];
    zero_acc(acc);
    gemm_kloop(yb + (size_t)TP * 1024, 1024, WbT + (size_t)nt * 128 * 1024, 1024, 1024, acc, smem);
    gemm_epilogue(acc, smem, TP, nt * 128, epiB);
  }
}

__device__ void phase_out(const P& p, char* smem) {
  const bf16_t* merged = (const bf16_t*)(p.ws + OFF_ACT);
  const bf16_t* WoutT = (const bf16_t*)(p.ws + OFF_WOUTT);
  const float* mod = (const float*)(p.ws + OFF_MOD);
  bf16_t* x1 = (bf16_t*)(p.ws + OFF_XBC);
  auto epi = [&](int row, int col, const float (&v)[8]) {
    const float* xr = (row < TP ? p.in[0] + (size_t)row * 1024 : p.in[1] + (size_t)(row - TP) * 1024) + col;
    const float* gt = mod + (size_t)mrow(row) * 6144 + 2048 + col;
    float4 a = *(const float4*)xr, b = *(const float4*)(xr + 4);
    float4 g0 = *(const float4*)gt, g1 = *(const float4*)(gt + 4);
    float o[8] = {a.x + g0.x * v[0], a.y + g0.y * v[1], a.z + g0.z * v[2], a.w + g0.w * v[3],
                  b.x + g1.x * v[4], b.y + g1.y * v[5], b.z + g1.z * v[6], b.w + g1.w * v[7]};
    store8bf(x1 + (size_t)row * 1024 + col, o);
  };
#pragma unroll 1
  for (int tile = blockIdx.x; tile < 512; tile += gridDim.x) {
    const int mt = tile >> 2, nt2 = tile & 3;
    f32x4 acc[4][8];
    zero_acc8(acc);
    gemm_kloop_n256(merged + (size_t)mt * 128 * 1024, 1024, WoutT + (size_t)nt2 * 256 * 1024, 1024, acc, smem);
    stage_all_bf16(acc, smem);
#pragma unroll 1
    for (int hh = 0; hh < 2; ++hh) epi_pass16(smem, hh, mt * 128, (nt2 * 2 + hh) * 128, epi);
    __syncthreads();
  }
#pragma unroll 1
  for (int nt = blockIdx.x; nt < 8; nt += gridDim.x) {
    f32x4 acc[4][4];
    zero_acc(acc);
    gemm_kloop(merged + (size_t)TP * 1024, 1024, WoutT + (size_t)nt * 128 * 1024, 1024, 1024, acc, smem);
    gemm_epilogue(acc, smem, TP, nt * 128, epi);
  }
}

__device__ void phase_query(const P& p, char* smem) {
  const bf16_t* h2 = (const bf16_t*)(p.ws + OFF_ACT);
  const bf16_t* WqT = (const bf16_t*)(p.ws + OFF_WQT);
  const bf16_t* keysB = (const bf16_t*)(p.ws + OFF_KEYS);
  float* topk1 = (float*)(p.ws + OFF_Z);
  const int tid = threadIdx.x, lane = tid & 63, wid = tid >> 6, wr = wid >> 1, wc = wid & 1, fr = lane & 15, fq = lane >> 4;
  for (int tile = blockIdx.x; tile < 129 * 16; tile += gridDim.x) {
    int mt = tile >> 4, nt = tile & 15;
    f32x4 acc[4][4];
    zero_acc(acc);
    gemm_kloop(h2 + (size_t)mt * 128 * 1024, 1024, WqT + (size_t)nt * 128 * 1024, 1024, 1024, acc, smem);
    bf16_t* Qs = (bf16_t*)smem;
    bf16_t* Ks = (bf16_t*)(smem + 34816);
#pragma unroll
    for (int m = 0; m < 4; ++m)
#pragma unroll
      for (int n = 0; n < 4; ++n)
#pragma unroll
        for (int r = 0; r < 4; ++r)
          Qs[(wr * 64 + m * 16 + fq * 4 + r) * 136 + wc * 64 + n * 16 + fr] = f2bf(acc[m][n][r]);
    {
      const bf16_t* kp = keysB + (size_t)nt * 16384;
#pragma unroll
      for (int i = 0; i < 8; ++i) {
        int idx = tid + 256 * i;
        int row = idx >> 4, c8 = (idx & 15) * 8;
        *(uint4*)(Ks + row * 136 + c8) = *(const uint4*)(kp + row * 128 + c8);
      }
    }
    __syncthreads();
    zero_acc(acc);
#pragma unroll
    for (int ks = 0; ks < 4; ++ks) {
      bf16x8 a[4], b[4];
#pragma unroll
      for (int m = 0; m < 4; ++m) a[m] = *(const bf16x8*)(Qs + (wr * 64 + m * 16 + fr) * 136 + ks * 32 + fq * 8);
#pragma unroll
      for (int n = 0; n < 4; ++n) b[n] = *(const bf16x8*)(Ks + (wc * 64 + n * 16 + fr) * 136 + ks * 32 + fq * 8);
#pragma unroll
      for (int m = 0; m < 4; ++m)
#pragma unroll
        for (int n = 0; n < 4; ++n)
          acc[m][n] = __builtin_amdgcn_mfma_f32_16x16x32_bf16(a[m], b[n], acc[m][n], 0, 0, 0);
    }
    __syncthreads();
    float* Sc = (float*)smem;
#pragma unroll
    for (int m = 0; m < 4; ++m)
#pragma unroll
      for (int n = 0; n < 4; ++n)
#pragma unroll
        for (int r = 0; r < 4; ++r) {
          int col = wc * 64 + n * 16 + fr;
          unsigned bits = (__float_as_uint(acc[m][n][r]) & ~127u) | (unsigned)(127 - col);
          Sc[(wr * 64 + m * 16 + fq * 4 + r) * 136 + col] = __uint_as_float(bits);
        }
    __syncthreads();
    {
      const int sub = lane & 15, grp = lane >> 4;
#pragma unroll 1
      for (int pass = 0; pass < 8; ++pass) {
        int row = wid * 32 + pass * 4 + grp;
        float v[8];
#pragma unroll
        for (int i = 0; i < 8; ++i) v[i] = Sc[row * 136 + sub + 16 * i];
#define CEX(i, j) { float hi_ = fmaxf(v[i], v[j]), lo_ = fminf(v[i], v[j]); v[i] = hi_; v[j] = lo_; }
        CEX(0, 1) CEX(2, 3) CEX(4, 5) CEX(6, 7)
        CEX(0, 2) CEX(1, 3) CEX(4, 6) CEX(5, 7)
        CEX(1, 2) CEX(5, 6)
        CEX(0, 4) CEX(1, 5) CEX(2, 6) CEX(3, 7)
        CEX(2, 4) CEX(3, 5)
        CEX(1, 2) CEX(3, 4) CEX(5, 6)
#undef CEX
        float mine = 0.f;
#pragma unroll
        for (int r = 0; r < 16; ++r) {
          const float m = row16_max(v[0]);
          const bool pop = (v[0] == m);
#pragma unroll
          for (int i = 0; i < 7; ++i) v[i] = pop ? v[i + 1] : v[i];
          v[7] = pop ? -INFINITY : v[7];
          if (sub == r) mine = m;
        }
        topk1[((size_t)(mt * 128 + row) * 16 + nt) * 16 + sub] = mine;
      }
    }
    __syncthreads();
  }
}

typedef __attribute__((ext_vector_type(2))) float f32x2_t;
DI void fp8x4_to_f32(unsigned w, float (&o)[4]) {
  f32x2_t lo = __builtin_amdgcn_cvt_pk_f32_fp8((int)w, false);
  f32x2_t hi = __builtin_amdgcn_cvt_pk_f32_fp8((int)w, true);
  o[0] = lo.x; o[1] = lo.y; o[2] = hi.x; o[3] = hi.y;
}
template <int NHD, bool COOP>
DI void peer_token(const P& p, char* smem, const int t, const int hd0, const int ci, const int cj) {
  const int lane = threadIdx.x & 63, wid = threadIdx.x >> 6;
  int* e_lds = (int*)(smem + wid * 4096);
  float* g_lds = (float*)(e_lds + 128);
  float* a_lds = g_lds + 128;
  float* sd_lds = a_lds + 128;
  float* su_lds = sd_lds + 128;
  const bf16_t* h2 = (const bf16_t*)(p.ws + OFF_ACT);
  const float* topk1 = (const float*)(p.ws + OFF_Z);
  const unsigned char* Ed = (const unsigned char*)(p.ws + OFF_E8);
  const unsigned char* Eu = Ed + 16777216;
  const float* Esc = (const float*)(p.ws + OFF_E8 + 33554432);
  const bf16_t* x1 = (const bf16_t*)(p.ws + OFF_XBC);
  const float* mod = (const float*)(p.ws + OFF_MOD);
  const float* modf = (const float*)(p.ws + OFF_MODF);
  const float* gfin = p.in[36];
  const int sub = lane & 15, grp = lane >> 4;
    f32x2_t hq2[32];
#pragma unroll
    for (int i = 0; i < 4; ++i) {
      const bf16_t* hp = h2 + (size_t)t * 1024 + i * 256 + sub * 16;
      uint4 u0 = *(const uint4*)hp, u1 = *(const uint4*)(hp + 8);
      float f0[8], f1[8];
      unpack8(u0, f0); unpack8(u1, f1);
#pragma unroll
      for (int j = 0; j < 4; ++j) {
        hq2[i * 8 + j] = f32x2_t{f0[2 * j], f0[2 * j + 1]};
        hq2[i * 8 + 4 + j] = f32x2_t{f1[2 * j], f1[2 * j + 1]};
      }
    }
    float tkv0[NHD], tkv1[NHD];
#pragma unroll
    for (int q = 0; q < NHD; ++q) {
      const float* tk = topk1 + ((size_t)t * 16 + (hd0 + q) * 2) * 16;
      tkv0[q] = tk[ci >= 0 ? ci : 0]; tkv1[q] = tk[16 + cj];
    }
#pragma unroll
    for (int hq_ = 0; hq_ < NHD; ++hq_) {
      const int hd = hd0 + hq_;
      float v0 = tkv0[hq_], v1 = tkv1[hq_];
      unsigned b0 = __float_as_uint(v0), b1 = __float_as_uint(v1);
      int i0 = 127 - (int)(b0 & 127u), i1 = 127 - (int)(b1 & 127u);
      float cand = __uint_as_float(b0 & ~127u) + __uint_as_float(b1 & ~127u);
      int eidx = i0 * 128 + i1;
      float key = (ci >= 0) ? __uint_as_float((__float_as_uint(cand) & ~63u) | (unsigned)(63 - lane)) : -INFINITY;
      int rank = 0;
#pragma unroll
      for (int j = 0; j < 50; ++j) {
        float kj = __builtin_bit_cast(float, __builtin_amdgcn_readlane(__builtin_bit_cast(int, key), j));
        rank += (kj > key) ? 1 : 0;
      }
      const bool sel = (ci >= 0) && (rank < 16);
      float fv = __uint_as_float(__float_as_uint(key) & ~63u);
      float mx = __builtin_bit_cast(float, __builtin_amdgcn_readlane(__builtin_bit_cast(int, fv), 0));
      float ex = sel ? __expf(fv - mx) : 0.f;
      float sm = wave_sum_fast(ex);
      if (sel) {
        e_lds[(hd - hd0) * 16 + rank] = eidx; g_lds[(hd - hd0) * 16 + rank] = ex / sm;
        sd_lds[(hd - hd0) * 16 + rank] = Esc[eidx]; su_lds[(hd - hd0) * 16 + rank] = Esc[16384 + eidx];
      }
    }
    __builtin_amdgcn_fence(__ATOMIC_RELEASE, "workgroup");
    __builtin_amdgcn_wave_barrier();
#pragma unroll 2
    for (int it = 0; it < NHD * 4; ++it) {
      int slot = it * 4 + grp;
      int e = e_lds[slot];
      const uint4* row = (const uint4*)(Ed + (size_t)e * 1024 + sub * 16);
      uint4 wv[4];
#pragma unroll
      for (int i = 0; i < 4; ++i) wv[i] = row[i * 16];
      f32x2_t acc2 = {0.f, 0.f}, acc3 = {0.f, 0.f};
#pragma unroll
      for (int i = 0; i < 4; ++i) {
        const unsigned ww[4] = {wv[i].x, wv[i].y, wv[i].z, wv[i].w};
#pragma unroll
        for (int j = 0; j < 4; ++j) {
          const f32x2_t lo = __builtin_amdgcn_cvt_pk_f32_fp8((int)ww[j], false);
          const f32x2_t hi = __builtin_amdgcn_cvt_pk_f32_fp8((int)ww[j], true);
          acc2 = lo * hq2[i * 8 + j * 2] + acc2;
          acc3 = hi * hq2[i * 8 + j * 2 + 1] + acc3;
        }
      }
      float acc = (acc2.x + acc2.y) + (acc3.x + acc3.y);
      acc = row16_sum(acc);
      if (sub == 0) a_lds[slot] = acc;
    }
    __builtin_amdgcn_fence(__ATOMIC_RELEASE, "workgroup");
    __builtin_amdgcn_wave_barrier();
#pragma unroll
    for (int s2 = lane; s2 < NHD * 16; s2 += 64)
      a_lds[s2] = geluf(a_lds[s2] * sd_lds[s2]) * g_lds[s2] * su_lds[s2];
    __builtin_amdgcn_fence(__ATOMIC_RELEASE, "workgroup");
    __builtin_amdgcn_wave_barrier();
    f32x2_t o2[8];
#pragma unroll
    for (int i = 0; i < 8; ++i) o2[i] = f32x2_t{0.f, 0.f};
#pragma unroll 8
    for (int s = 0; s < NHD * 16; ++s) {
      int e = e_lds[s];
      const float a = a_lds[s];
      const f32x2_t a2 = {a, a};
      uint4 w = *(const uint4*)(Eu + (size_t)e * 1024 + lane * 16);
      const unsigned ww[4] = {w.x, w.y, w.z, w.w};
#pragma unroll
      for (int j = 0; j < 4; ++j) {
        o2[2 * j] = __builtin_amdgcn_cvt_pk_f32_fp8((int)ww[j], false) * a2 + o2[2 * j];
        o2[2 * j + 1] = __builtin_amdgcn_cvt_pk_f32_fp8((int)ww[j], true) * a2 + o2[2 * j + 1];
      }
    }
    float o[16];
#pragma unroll
    for (int i = 0; i < 8; ++i) { o[2 * i] = o2[i].x; o[2 * i + 1] = o2[i].y; }
    if (COOP) {
      float* part = (float*)(smem + 16384);
#pragma unroll
      for (int i = 0; i < 16; ++i) part[wid * 1024 + lane * 16 + i] = o[i];
      __syncthreads();
      if (wid != 0) return;
#pragma unroll
      for (int i = 0; i < 16; ++i) o[i] = part[lane * 16 + i] + part[1024 + lane * 16 + i] + part[2048 + lane * 16 + i] + part[3072 + lane * 16 + i];
    }
    const int mr = mrow(t);
    const int c0 = lane * 16;
    float x2[16];
    float ss = 0.f;
    {
      const bf16_t* xr = x1 + (size_t)t * 1024 + c0;
      const float* gt = mod + (size_t)mr * 6144 + 5120 + c0;
      uint4 xa = *(const uint4*)xr, xb2 = *(const uint4*)(xr + 8);
      float xf[16];
      {
        float f0[8], f1[8];
        unpack8(xa, f0); unpack8(xb2, f1);
#pragma unroll
        for (int i = 0; i < 8; ++i) { xf[i] = f0[i]; xf[8 + i] = f1[i]; }
      }
#pragma unroll
      for (int q = 0; q < 4; ++q) {
        float4 g = *(const float4*)(gt + 4 * q);
        x2[4 * q + 0] = xf[4 * q + 0] + g.x * o[4 * q + 0]; x2[4 * q + 1] = xf[4 * q + 1] + g.y * o[4 * q + 1];
        x2[4 * q + 2] = xf[4 * q + 2] + g.z * o[4 * q + 2]; x2[4 * q + 3] = xf[4 * q + 3] + g.w * o[4 * q + 3];
      }
    }
#pragma unroll
    for (int i = 0; i < 16; ++i) ss += x2[i] * x2[i];
    ss = wave_sum_fast(ss);
    float rs = rsqrtf(ss * (1.f / 1024.f) + 1e-6f);
    {
      const float* sh = modf + (size_t)mr * 2048 + c0;
      const float* sc = sh + 1024;
      float* d = p.out + O_Y + (size_t)t * 1024 + c0;
#pragma unroll
      for (int q = 0; q < 4; ++q) {
        float4 shv = *(const float4*)(sh + 4 * q), scv = *(const float4*)(sc + 4 * q), gf = *(const float4*)(gfin + c0 + 4 * q);
        float4 y;
        y.x = x2[4 * q + 0] * rs * gf.x * (1.f + scv.x) + shv.x;
        y.y = x2[4 * q + 1] * rs * gf.y * (1.f + scv.y) + shv.y;
        y.z = x2[4 * q + 2] * rs * gf.z * (1.f + scv.z) + shv.z;
        y.w = x2[4 * q + 3] * rs * gf.w * (1.f + scv.w) + shv.w;
        *(float4*)(d + 4 * q) = y;
      }
    }
    __builtin_amdgcn_fence(__ATOMIC_RELEASE, "workgroup");
    __builtin_amdgcn_wave_barrier();
}

__device__ void phase_peer(const P& p, char* smem) {
  const int lane = threadIdx.x & 63, wid = threadIdx.x >> 6;
  int ci = -1, cj = 0;
  {
    int c = lane;
#pragma unroll
    for (int i = 0; i < 16; ++i) {
      int cnt = 16 / (i + 1);
      if (ci < 0) { if (c < cnt) { ci = i; cj = c; } else c -= cnt; }
    }
  }
#pragma unroll 1
  for (int t = blockIdx.x * 4 + wid; t < TP; t += gridDim.x * 4) peer_token<8, false>(p, smem, t, 0, ci, cj);
#pragma unroll 1
  for (int b = blockIdx.x; b < TT - TP; b += gridDim.x) {
    __syncthreads();
    peer_token<2, true>(p, smem, TP + b, wid * 2, ci, cj);
    __syncthreads();
  }
}

template <int PH>
DI void run_phase(const P& p, char* smem) {
  if constexpr (PH == 0) phase0(p, smem);
  else if constexpr (PH == 1) phase_mod(p, smem);
  else if constexpr (PH == 2) phase_norm(p, 0);
  else if constexpr (PH == 3) phase_inproj(p, smem);
  else if constexpr (PH == 4) phase_mixers(p, smem);
  else if constexpr (PH == 5) phase_glu(p, smem);
  else if constexpr (PH == 6) phase_merge(p, smem);
  else if constexpr (PH == 7) phase_out(p, smem);
  else if constexpr (PH == 8) phase_norm(p, 1);
  else if constexpr (PH == 9) phase_query(p, smem);
  else phase_peer(p, smem);
}

#define XB_TMO      128
#define XB_XCNT(j)  (256  + 64 * (j))
#define XB_XSUB(j)  (1280 + 64 * (j))
#define XB_XGEN(j)  (2304 + 64 * (j))
#define XB_TOP      3328
#define XB_TOPGEN   3392
#define XCD_BAR_WORDS 3456
#define XB_SPIN_CAP (1u << 20)
#define LAS __attribute__((address_space(3)))

__device__ __forceinline__ unsigned xb_ld(unsigned* p)              { return __hip_atomic_load(p, __ATOMIC_RELAXED, __HIP_MEMORY_SCOPE_AGENT); }
__device__ __forceinline__ unsigned xb_add(unsigned* p, unsigned v) { return __hip_atomic_fetch_add(p, v, __ATOMIC_RELAXED, __HIP_MEMORY_SCOPE_AGENT); }
__device__ __forceinline__ unsigned xb_xcc_id() { return (unsigned)__builtin_amdgcn_s_getreg((3 << 11) | 20) & 0xFu; }
#define XB_SPIN(cond, bar) do { unsigned _sp = 0; while (cond) { __builtin_amdgcn_s_sleep(1); \
    if ((++_sp & 255u) == 0u) { if (xb_ld(&(bar)[XB_TMO])) break; if (_sp > XB_SPIN_CAP) { atomicAdd(&(bar)[XB_TMO], 1u); break; } } } } while (0)

struct XcdBarrier {
    unsigned* bar; unsigned x;
    volatile LAS unsigned* st;
};

__device__ __forceinline__ XcdBarrier xcd_barrier_post(unsigned* bar, volatile LAS unsigned* st) {
    XcdBarrier b; b.bar = bar; b.x = xb_xcc_id(); b.st = st;
    if (threadIdx.x == 0) (void)xb_add(&bar[XB_XCNT(b.x)], 1u);
    return b;
}
__device__ __forceinline__ void xcd_barrier_complete(unsigned* bar, unsigned x, unsigned& nloc, unsigned& nx) {
    const unsigned G = gridDim.x * gridDim.y * gridDim.z;
    unsigned sum, cnt, mine, sp = 0u;
    for (;;) {
        sum = 0u; cnt = 0u; mine = 0u;
#pragma unroll
        for (unsigned j = 0; j < 16; ++j) { const unsigned c = xb_ld(&bar[XB_XCNT(j)]); sum += c; cnt += (c > 0u) ? 1u : 0u; mine = (j == x) ? c : mine; }
        if (sum == G) break;
        __builtin_amdgcn_s_sleep(1);
        if ((++sp & 255u) == 0u) { if (xb_ld(&bar[XB_TMO])) break; if (sp > XB_SPIN_CAP) { atomicAdd(&bar[XB_TMO], 1u); break; } }
    }
    nloc = mine > 0u ? mine : 1u; nx = cnt > 0u ? cnt : 1u;
}

__device__ __forceinline__ void xcd_barrier(const XcdBarrier& b) {
    asm volatile("s_waitcnt vmcnt(0)" ::: "memory");
    __syncthreads();
    if (threadIdx.x == 0) {
        unsigned* bar = b.bar;
        __builtin_amdgcn_s_waitcnt(0);
        unsigned nloc = b.st[0], nx = b.st[1];
        if (nloc == 0u) { xcd_barrier_complete(bar, b.x, nloc, nx); b.st[0] = nloc; b.st[1] = nx; }
        const unsigned old = xb_add(&bar[XB_XSUB(b.x)], 1u);
        const unsigned gen = old / nloc;
        if (old + 1u == (gen + 1u) * nloc) {
            __builtin_amdgcn_fence(__ATOMIC_RELEASE, "agent");
            asm volatile("s_waitcnt vmcnt(0)" ::: "memory");
            const unsigned og = xb_add(&bar[XB_TOP], 1u);
            const unsigned tg = og / nx;
            if (og + 1u == (tg + 1u) * nx) xb_add(&bar[XB_TOPGEN], 1u);
            else XB_SPIN(xb_ld(&bar[XB_TOPGEN]) == tg, bar);
            __builtin_amdgcn_fence(__ATOMIC_ACQUIRE, "agent");
            xb_add(&bar[XB_XGEN(b.x)], 1u);
            asm volatile("s_waitcnt vmcnt(0)" ::: "memory");
        } else {
            XB_SPIN(xb_ld(&bar[XB_XGEN(b.x)]) == gen, bar);
            __builtin_amdgcn_fence(__ATOMIC_ACQUIRE, "agent");
            asm volatile("s_waitcnt vmcnt(0)" ::: "memory");
        }
    }
    __syncthreads();
}


__global__ void __launch_bounds__(256, 2) mega(P p) {
  extern __shared__ __attribute__((aligned(16))) char smem[];
  cg::grid_group grid = cg::this_grid();
  if (threadIdx.x == 0) *(uint4*)(smem + 80384) = make_uint4(0u, 0u, 0u, 0u);
  __syncthreads();
  XcdBarrier xb = xcd_barrier_post((unsigned*)(p.ws + OFF_BAR), (volatile LAS unsigned*)(smem + 80384));
  if (p.ws == nullptr) grid.sync();
  run_phase<0>(p, smem);  xcd_barrier(xb);
  run_phase<1>(p, smem);  xcd_barrier(xb);
  run_phase<2>(p, smem);  xcd_barrier(xb);
  run_phase<3>(p, smem);  xcd_barrier(xb);
  phase_convfix(p);       xcd_barrier(xb);
  run_phase<4>(p, smem);  xcd_barrier(xb);
  run_phase<5>(p, smem);  xcd_barrier(xb);
  run_phase<6>(p, smem);  xcd_barrier(xb);
  run_phase<7>(p, smem);  xcd_barrier(xb);
  run_phase<8>(p, smem);  xcd_barrier(xb);
  run_phase<9>(p, smem);  xcd_barrier(xb);
  run_phase<10>(p, smem);
}

extern "C" void kernel_launch(void* const* d_in, const int* in_sizes, int n_in, void* d_out, int out_size,
                              void* d_ws, size_t ws_size, hipStream_t stream) {
  static int grid_blocks = 0;
  if (!grid_blocks) {
    int dev = 0, cus = 0, per_cu = 0;
    (void)hipGetDevice(&dev);
    (void)hipDeviceGetAttribute(&cus, hipDeviceAttributeMultiprocessorCount, dev);
    (void)hipFuncSetAttribute((const void*)mega, hipFuncAttributeMaxDynamicSharedMemorySize, SMEM_BYTES);
    (void)hipOccupancyMaxActiveBlocksPerMultiprocessor(&per_cu, mega, 256, SMEM_BYTES);
    if (per_cu < 1) per_cu = 1;
    if (per_cu > 2) per_cu = 2;
    grid_blocks = cus * per_cu;
  }
  if (ws_size < WS_NEED) { fprintf(stderr, "workspace too small: %zu < %zu\n", ws_size, (size_t)WS_NEED); return; }
  P p{};
  for (int i = 0; i < 39; ++i) p.in[i] = (const float*)d_in[i];
  p.out = (float*)d_out;
  p.ws = (char*)d_ws;
  (void)hipMemsetAsync((char*)d_ws + OFF_BAR, 0, 16384, stream);
  void* args[] = {&p};
  hipError_t e = hipLaunchCooperativeKernel((void*)mega, dim3(grid_blocks), dim3(256), args, SMEM_BYTES, stream);
  if (e != hipSuccess) fprintf(stderr, "cooperative launch failed: %s (grid %d)\n", hipGetErrorString(e), grid_blocks);
}
```
